# Optimizing an MI355X kernel written in HIP

```python
import jax, jax.numpy as jnp
from jax import lax
import numpy as np

D_MODEL = 1024
BATCH = 8
SEQ = 2048
DEPTH = 1

MEM_LEN = 256
CONV_W = D_MODEL
CONV_K = 3
SB_HEADS = 8
SB_HEAD_DIM = 128
SB_W = SB_HEADS * SB_HEAD_DIM
Q_BLOCK = 128
X_HEADS = 4
X_HEAD_DIM = D_MODEL // X_HEADS
D_FF = 2816
RMS_EPS = 1e-6
PROJ_SIZES = (CONV_W, CONV_W, CONV_W, SB_W, SB_W, SB_W, D_MODEL, D_MODEL)

kernel_name = 'hybrid_conv_stickbreak_macaron_layer'


def rms_norm(x, g):
    xf = x.astype(jnp.float32)
    y = xf * lax.rsqrt(jnp.mean(xf * xf, axis=-1, keepdims=True) + RMS_EPS)
    return (y * g.astype(jnp.float32)).astype(x.dtype)


def swiglu(x, w_gu, w_down):
    gate, up = jnp.split(x @ w_gu, 2, axis=-1)
    return (jax.nn.silu(gate) * up) @ w_down


def short_conv(x, w):
    c = x.shape[-1]
    return lax.conv_general_dilated(
        x, w[:, None, :].astype(x.dtype), window_strides=(1,), padding=[(CONV_K - 1, 0)],
        dimension_numbers=('NWC', 'WIO', 'NWC'), feature_group_count=c)


def stick_breaking_attention(q, k, v):
    seq = q.shape[2]
    scale = SB_HEAD_DIM ** -0.5
    outs = []
    for blk in range(seq // Q_BLOCK):
        start = blk * Q_BLOCK
        end = start + Q_BLOCK
        z = jnp.einsum('bhqd,bhkd->bhqk', q[:, :, start:end], k[:, :, :end]).astype(jnp.float32) * scale
        t_pos = start + jnp.arange(Q_BLOCK)[:, None]
        s_pos = jnp.arange(end)[None, :]
        causal = s_pos < t_pos
        log_1m_beta = jnp.where(causal, jax.nn.log_sigmoid(-z), 0.0)
        after = lax.cumsum(log_1m_beta, axis=3, reverse=True) - log_1m_beta
        a = jnp.where(causal, jnp.exp(jax.nn.log_sigmoid(z) + after), 0.0)
        outs.append(jnp.einsum('bhqk,bhkd->bhqd', a, v[:, :, :end].astype(jnp.float32)))
    return jnp.concatenate(outs, axis=2).astype(q.dtype)


def memory_cross_attention(hn, mn, w_cq, w_ckv, w_co):
    b, s, _ = hn.shape
    m = mn.shape[1]
    q = (hn @ w_cq).reshape(b, s, X_HEADS, X_HEAD_DIM)
    k, v = jnp.split(mn @ w_ckv, 2, axis=-1)
    k = k.reshape(b, m, X_HEADS, X_HEAD_DIM)
    v = v.reshape(b, m, X_HEADS, X_HEAD_DIM)
    scores = jnp.einsum('bshd,bmhd->bhsm', q, k).astype(jnp.float32) * (X_HEAD_DIM ** -0.5)
    p = jax.nn.softmax(scores, axis=-1)
    o = jnp.einsum('bhsm,bmhd->bshd', p, v.astype(jnp.float32)).astype(hn.dtype)
    return o.reshape(b, s, D_MODEL) @ w_co


def hybrid_mixer(u, w_in, b_gate, conv_w, w_conv_out, w_attn_out, w_o):
    b, s, _ = u.shape
    split_at = np.cumsum(PROJ_SIZES)[:6].tolist()
    cb, cc, cx, q, k, v, gates = jnp.split(u @ w_in, split_at, axis=-1)
    gate_pre = gates + b_gate
    g_conv, g_sb = jnp.split(jax.nn.sigmoid(gate_pre), 2, axis=-1)
    y_conv = cb * short_conv(cc * cx, conv_w)
    to_heads = lambda t: t.reshape(b, s, SB_HEADS, SB_HEAD_DIM).transpose(0, 2, 1, 3)
    y_sb = stick_breaking_attention(to_heads(q), to_heads(k), to_heads(v))
    y_sb = y_sb.transpose(0, 2, 1, 3).reshape(b, s, SB_W)
    merged = g_conv * (y_conv @ w_conv_out) + g_sb * (y_sb @ w_attn_out)
    return merged @ w_o


def setup_inputs(seed: int = 0) -> dict:
    key = jax.random.key(seed)
    ks = jax.random.split(key, 21)
    f32 = jnp.float32

    def dense(k, shape):
        return jax.random.normal(k, shape, f32) * (shape[0] ** -0.5)

    def gain(k):
        return 1.0 + 0.01 * jax.random.normal(k, (D_MODEL,), f32)

    return {
        'x': jax.random.normal(ks[0], (BATCH, SEQ, D_MODEL), f32),
        'mem': jax.random.normal(ks[1], (BATCH, MEM_LEN, D_MODEL), f32),
        'g_ffn1': gain(ks[2]),
        'w_ffn1_gu': dense(ks[3], (D_MODEL, 2 * D_FF)),
        'w_ffn1_down': dense(ks[4], (D_FF, D_MODEL)),
        'g_mix': gain(ks[5]),
        'w_in': dense(ks[6], (D_MODEL, sum(PROJ_SIZES))),
        'b_gate': 0.01 * jax.random.normal(ks[7], (2 * D_MODEL,), f32),
        'conv_w': jax.random.normal(ks[8], (CONV_K, CONV_W), f32) * (CONV_K ** -0.5),
        'w_conv_out': dense(ks[9], (CONV_W, D_MODEL)),
        'w_attn_out': dense(ks[10], (SB_W, D_MODEL)),
        'w_o': dense(ks[11], (D_MODEL, D_MODEL)),
        'g_cross': gain(ks[12]),
        'g_mem': gain(ks[13]),
        'w_cq': dense(ks[14], (D_MODEL, D_MODEL)),
        'w_ckv': dense(ks[15], (D_MODEL, 2 * D_MODEL)),
        'w_co': dense(ks[16], (D_MODEL, D_MODEL)),
        'g_ffn2': gain(ks[17]),
        'w_ffn2_gu': dense(ks[18], (D_MODEL, 2 * D_FF)),
        'w_ffn2_down': dense(ks[19], (D_FF, D_MODEL)),
        'g_final': gain(ks[20]),
    }


def reference(x, mem, g_ffn1, w_ffn1_gu, w_ffn1_down, g_mix, w_in, b_gate, conv_w,
              w_conv_out, w_attn_out, w_o, g_cross, g_mem, w_cq, w_ckv, w_co,
              g_ffn2, w_ffn2_gu, w_ffn2_down, g_final):
    h = x
    for _ in range(DEPTH):
        h = h + 0.5 * swiglu(rms_norm(h, g_ffn1), w_ffn1_gu, w_ffn1_down)
        h = h + hybrid_mixer(rms_norm(h, g_mix), w_in, b_gate, conv_w, w_conv_out, w_attn_out, w_o)
        h = h + memory_cross_attention(rms_norm(h, g_cross), rms_norm(mem, g_mem), w_cq, w_ckv, w_co)
        h = h + 0.5 * swiglu(rms_norm(h, g_ffn2), w_ffn2_gu, w_ffn2_down)
    return rms_norm(h, g_final)
```

```cpp
#include <hip/hip_runtime.h>
#include <hip/hip_cooperative_groups.h>
#include <cstdio>
#include <cstdint>
namespace cg = cooperative_groups;
namespace pg8 {
#define PG8_LAS __attribute__((address_space(3)))
typedef unsigned short bf16_t;
typedef short bf16x8 __attribute__((ext_vector_type(8)));
typedef float f32x4 __attribute__((ext_vector_type(4)));
typedef unsigned u32x4 __attribute__((ext_vector_type(4)));
constexpr int BM = 256, BK = 64, HALF = 128, HTB = HALF * BK * 2  , STAGE_BYTES = 8 * HTB, NXCD = 8, WGM = 8;

__host__ __device__ __forceinline__ int lds_byte(int r, int c) { const int st = (r >> 4) * 2 + (c >> 5), rr = r & 15, cc = c & 31, ob = rr * 64 + cc * 2; return st * 1024 + (ob ^ (((ob >> 9) & 1) << 5)); }
__host__ __device__ __forceinline__ void stage_rc(int b, int& R, int& C) { const int st = b / 1024, sb = b % 1024, swz = sb ^ (((sb >> 9) & 1) << 5); R = (st >> 1) * 16 + swz / 64; C = (st & 1) * 32 + (swz % 64) / 2; }
__host__ __device__ __forceinline__ int perm32(int rho) { const int n = rho >> 4, i = rho & 15; return 8 * (i >> 2) + 4 * n + (i & 3); }

struct Unit { int pm, pn, job; };
struct Gemm { const bf16_t* A; const bf16_t* Bt; int M, N, K; };

struct StaticOrder {
    int nM, nN, nwg, G, c;
    __host__ __device__ void init(int M, int N, int G_, int c_) { nM = M / BM; nN = N / BM; nwg = nM * nN; G = G_; c = c_; }
    __host__ __device__ bool next(int i, Unit& u) const {
        const long L = (long)i * G + c; if (L >= nwg) return false;
        int wgid = (int)L; { const int q = nwg / NXCD, r = nwg % NXCD, xcd = wgid % NXCD, off = wgid / NXCD; wgid = (xcd < r ? xcd * (q + 1) : r * (q + 1) + (xcd - r) * q) + off; }
        const int nig = WGM * nN, gid = wgid / nig, fm = gid * WGM, gsz = (nM - fm) < WGM ? (nM - fm) : WGM;
        u.pm = fm + ((wgid % nig) % gsz); u.pn = (wgid % nig) / gsz; u.job = 0; return true;
    }
    __device__ __forceinline__ const char* baseA(const Gemm& g, const Unit&) const { return (const char*)g.A; }
    __device__ __forceinline__ const char* baseB(const Gemm& g, const Unit&) const { return (const char*)g.Bt; }
    __device__ __forceinline__ void a_ready(const Unit&) const {}
    __device__ __forceinline__ void done(const Unit&) const {}
};

typedef __bf16 bf16x2_t __attribute__((ext_vector_type(2)));
typedef float f32x2_t __attribute__((ext_vector_type(2)));
__device__ __forceinline__ unsigned cvt_pk_bf16(float lo, float hi) { f32x2_t v = {lo, hi}; bf16x2_t b = __builtin_convertvector(v, bf16x2_t); return __builtin_bit_cast(unsigned, b); }
__device__ __forceinline__ u32x4 pack8(f32x4 a, f32x4 b) { u32x4 w; w.x = cvt_pk_bf16(a[0], a[1]); w.y = cvt_pk_bf16(a[2], a[3]); w.z = cvt_pk_bf16(b[0], b[1]); w.w = cvt_pk_bf16(b[2], b[3]); return w; }
__device__ __forceinline__ float bf_lo(unsigned w) { return __builtin_bit_cast(float, w << 16); }
__device__ __forceinline__ float bf_hi(unsigned w) { return __builtin_bit_cast(float, w & 0xffff0000u); }
__device__ __forceinline__ void unpack8(u32x4 w, f32x4& a, f32x4& b) { a = (f32x4){bf_lo(w.x), bf_hi(w.x), bf_lo(w.y), bf_hi(w.y)}; b = (f32x4){bf_lo(w.z), bf_hi(w.z), bf_lo(w.w), bf_hi(w.w)}; }
constexpr float RMS_EPS_F = 1e-6f;
__device__ __forceinline__ float rs_of(float ssq) { return __builtin_amdgcn_rsqf(ssq * (1.f / 1024.f) + RMS_EPS_F); }
__device__ __forceinline__ float sigmoid_f(float v) { return __builtin_amdgcn_rcpf(1.f + __builtin_amdgcn_exp2f(-1.4426950408889634f * v)); }

struct EpiSwiGLU {
    static constexpr bool PERM = true, AFTER_DRAIN = false;
    bf16_t* O; const float* ssq; int ldo;
    __device__ __forceinline__ void operator()(const f32x4 (&acc)[2][2][4][2], const Unit& u, int wr, int wc, int fr, int fq) const {
        const int row0 = u.pm * BM + wr * 64 + fr, col0 = u.pn * HALF + wc * 32 + 8 * fq;
        float sv[2][4];
#pragma unroll
        for (int ai = 0; ai < 2; ++ai)
#pragma unroll
            for (int m = 0; m < 4; ++m) sv[ai][m] = ssq[row0 + ai * HALF + m * 16];
#pragma unroll
        for (int ai = 0; ai < 2; ++ai)
#pragma unroll
            for (int m = 0; m < 4; ++m) { const int row = row0 + ai * HALF + m * 16; const float r = rs_of(sv[ai][m]);
                f32x4 o[2];
#pragma unroll
                for (int n = 0; n < 2; ++n) { const f32x4 g = acc[ai][0][m][n] * r, up = acc[ai][1][m][n] * r;
#pragma unroll
                    for (int e = 0; e < 4; ++e) o[n][e] = g[e] * sigmoid_f(g[e]) * up[e]; }
                *(u32x4*)(O + (size_t)row * ldo + col0) = pack8(o[0], o[1]); }
    }
};

struct EpiResid {
    static constexpr bool PERM = true, AFTER_DRAIN = false;
    bf16_t* HB; float* ssq; float alpha;
    __device__ __forceinline__ void operator()(const f32x4 (&acc)[2][2][4][2], const Unit& u, int wr, int wc, int fr, int fq) const {
        const int row0 = u.pm * BM + wr * 64 + fr, col0 = u.pn * BM + wc * 32 + 8 * fq;
#pragma unroll
        for (int ai = 0; ai < 2; ++ai)
#pragma unroll
            for (int m = 0; m < 4; ++m) { const int row = row0 + ai * HALF + m * 16; float ss = 0.f;
#pragma unroll
                for (int bj = 0; bj < 2; ++bj) { const size_t off = (size_t)row * 1024 + col0 + bj * HALF;
                    f32x4 a, b; unpack8(*(const u32x4*)(HB + off), a, b);
                    a = a + acc[ai][bj][m][0] * alpha; b = b + acc[ai][bj][m][1] * alpha;
                    *(u32x4*)(HB + off) = pack8(a, b);
                    ss += (a[0] * a[0] + a[1] * a[1]) + (a[2] * a[2] + a[3] * a[3]) + (b[0] * b[0] + b[1] * b[1]) + (b[2] * b[2] + b[3] * b[3]); }
                ss += __shfl_xor(ss, 16); ss += __shfl_xor(ss, 32);
                if (fq == 0) unsafeAtomicAdd(ssq + row, ss); }
    }
};

struct EpiMixIn {
    static constexpr bool PERM = true, AFTER_DRAIN = false;
    bf16_t *CB, *CCX, *Q, *Kb; const float* ssq; float qscale;
    __device__ __forceinline__ void operator()(const f32x4 (&acc)[2][2][4][2], const Unit& u, int wr, int wc, int fr, int fq) const {
        const int row0 = u.pm * BM + wr * 64 + fr, pn = u.pn;
        float sv[2][4];
#pragma unroll
        for (int ai = 0; ai < 2; ++ai)
#pragma unroll
            for (int m = 0; m < 4; ++m) sv[ai][m] = ssq[row0 + ai * HALF + m * 16];
        if (pn >= 4 && pn < 12) {
            const int col0 = (pn - 4) * HALF + wc * 32 + 8 * fq;
#pragma unroll
            for (int ai = 0; ai < 2; ++ai)
#pragma unroll
                for (int m = 0; m < 4; ++m) { const int row = row0 + ai * HALF + m * 16; const float r = rs_of(sv[ai][m]), r2 = r * r;
                    *(u32x4*)(CCX + (size_t)row * 1024 + col0) = pack8(acc[ai][0][m][0] * acc[ai][1][m][0] * r2, acc[ai][0][m][1] * acc[ai][1][m][1] * r2); }
        } else {
            bf16_t* base; int colt; float sc = 1.f;
            if (pn < 4) { base = CB; colt = pn * BM; } else if (pn < 16) { base = Q; colt = (pn - 12) * BM; sc = qscale; } else { base = Kb; colt = (pn - 16) * BM; }
            const int col0 = colt + wc * 32 + 8 * fq;
#pragma unroll
            for (int ai = 0; ai < 2; ++ai)
#pragma unroll
                for (int m = 0; m < 4; ++m) { const int row = row0 + ai * HALF + m * 16; const float r = rs_of(sv[ai][m]) * sc;
#pragma unroll
                    for (int bj = 0; bj < 2; ++bj) *(u32x4*)(base + (size_t)row * 1024 + col0 + bj * HALF) = pack8(acc[ai][bj][m][0] * r, acc[ai][bj][m][1] * r); }
        }
    }
};

struct EpiVt {
    static constexpr bool PERM = true, AFTER_DRAIN = false;
    bf16_t* O; const float* ssq;
    __device__ __forceinline__ void operator()(const f32x4 (&acc)[2][2][4][2], const Unit& u, int wr, int wc, int fr, int fq) const {
        const int ch0 = u.pm * BM + wr * 64 + fr, tok0 = u.pn * BM + wc * 32 + 8 * fq;
        f32x4 sc[2][2];
#pragma unroll
        for (int bj = 0; bj < 2; ++bj)
#pragma unroll
            for (int n = 0; n < 2; ++n) {
                if (ssq) { const f32x4 s = *(const f32x4*)(ssq + tok0 + bj * HALF + 4 * n); sc[bj][n] = (f32x4){rs_of(s[0]), rs_of(s[1]), rs_of(s[2]), rs_of(s[3])}; }
                else sc[bj][n] = (f32x4){1.f, 1.f, 1.f, 1.f}; }
#pragma unroll
        for (int ai = 0; ai < 2; ++ai)
#pragma unroll
            for (int m = 0; m < 4; ++m) { const int ch = ch0 + ai * HALF + m * 16;
#pragma unroll
                for (int bj = 0; bj < 2; ++bj) { const int tok = tok0 + bj * HALF;
                    *(u32x4*)(O + ((size_t)(tok >> 11) * 1024 + ch) * 2048 + (tok & 2047)) = pack8(acc[ai][bj][m][0] * sc[bj][0], acc[ai][bj][m][1] * sc[bj][1]); } }
    }
};

template <int SIG> struct EpiGen {
    static constexpr bool PERM = true, AFTER_DRAIN = false;
    bf16_t* O; int ldc; const float* ssq; float sc; const float* bias;
    __device__ __forceinline__ void operator()(const f32x4 (&acc)[2][2][4][2], const Unit& u, int wr, int wc, int fr, int fq) const {
        const int row0 = u.pm * BM + wr * 64 + fr, col0 = u.pn * BM + wc * 32 + 8 * fq;
        f32x4 bv[2][2];
#pragma unroll
        for (int bj = 0; bj < 2; ++bj)
#pragma unroll
            for (int n = 0; n < 2; ++n) bv[bj][n] = bias ? *(const f32x4*)(bias + col0 + bj * HALF + 4 * n) : (f32x4){0.f, 0.f, 0.f, 0.f};
        float sv[2][4];
#pragma unroll
        for (int ai = 0; ai < 2; ++ai)
#pragma unroll
            for (int m = 0; m < 4; ++m) sv[ai][m] = ssq ? ssq[row0 + ai * HALF + m * 16] : 0.f;
#pragma unroll
        for (int ai = 0; ai < 2; ++ai)
#pragma unroll
            for (int m = 0; m < 4; ++m) { const int row = row0 + ai * HALF + m * 16; const float r = (ssq ? rs_of(sv[ai][m]) : 1.f) * sc;
#pragma unroll
                for (int bj = 0; bj < 2; ++bj) { f32x4 v0 = acc[ai][bj][m][0] * r + bv[bj][0], v1 = acc[ai][bj][m][1] * r + bv[bj][1];
                    if (SIG) {
#pragma unroll
                        for (int e = 0; e < 4; ++e) { v0[e] = sigmoid_f(v0[e]); v1[e] = sigmoid_f(v1[e]); } }
                    *(u32x4*)(O + (size_t)row * ldc + col0 + bj * HALF) = pack8(v0, v1); } }
    }
};

template <int ADD> struct EpiGateMul {
    static constexpr bool PERM = true, AFTER_DRAIN = false;
    bf16_t* G; const bf16_t* T;
    __device__ __forceinline__ void operator()(const f32x4 (&acc)[2][2][4][2], const Unit& u, int wr, int wc, int fr, int fq) const {
        const int row0 = u.pm * BM + wr * 64 + fr, col0 = u.pn * BM + wc * 32 + 8 * fq;
#pragma unroll
        for (int ai = 0; ai < 2; ++ai)
#pragma unroll
            for (int m = 0; m < 4; ++m) { const int row = row0 + ai * HALF + m * 16;
#pragma unroll
                for (int bj = 0; bj < 2; ++bj) { const size_t off = (size_t)row * 1024 + col0 + bj * HALF;
                    f32x4 g0, g1; unpack8(*(const u32x4*)(G + off), g0, g1);
                    f32x4 v0 = g0 * acc[ai][bj][m][0], v1 = g1 * acc[ai][bj][m][1];
                    if (ADD) { f32x4 t0, t1; unpack8(*(const u32x4*)(T + off), t0, t1); v0 = v0 + t0; v1 = v1 + t1; }
                    *(u32x4*)(G + off) = pack8(v0, v1); } }
    }
};

struct EpiFinal {
    static constexpr bool PERM = true, AFTER_DRAIN = false;
    const bf16_t* Hin; float* Out; float* ssq; float alpha; const float* gain; unsigned* cnt;
    __device__ __forceinline__ void operator()(const f32x4 (&acc_)[2][2][4][2], const Unit& u, int wr, int wc, int fr, int fq) const {
        f32x4 (&acc)[2][2][4][2] = const_cast<f32x4 (&)[2][2][4][2]>(acc_);
        const int row0 = u.pm * BM + wr * 64 + fr, col0 = u.pn * BM + wc * 32 + 8 * fq;
#pragma unroll
        for (int ai = 0; ai < 2; ++ai)
#pragma unroll
            for (int m = 0; m < 4; ++m) { const int row = row0 + ai * HALF + m * 16; float ss = 0.f;
#pragma unroll
                for (int bj = 0; bj < 2; ++bj) { const size_t off = (size_t)row * 1024 + col0 + bj * HALF;
                    f32x4 a, b; unpack8(*(const u32x4*)(Hin + off), a, b);
                    a = a + acc[ai][bj][m][0] * alpha; b = b + acc[ai][bj][m][1] * alpha;
                    acc[ai][bj][m][0] = a; acc[ai][bj][m][1] = b;
                    ss += (a[0] * a[0] + a[1] * a[1]) + (a[2] * a[2] + a[3] * a[3]) + (b[0] * b[0] + b[1] * b[1]) + (b[2] * b[2] + b[3] * b[3]); }
                ss += __shfl_xor(ss, 16); ss += __shfl_xor(ss, 32);
                if (fq == 0) unsafeAtomicAdd(ssq + row, ss); }
        asm volatile("s_waitcnt vmcnt(0)" ::: "memory");
        unsigned* pc = cnt + u.pm * 32;
        unsigned* pf = pc + 2048;
        if (fr == 0 && fq == 0) { if (__hip_atomic_fetch_add(pc, 1u, __ATOMIC_RELAXED, __HIP_MEMORY_SCOPE_AGENT) == 31u) __hip_atomic_store(pf, 1u, __ATOMIC_RELAXED, __HIP_MEMORY_SCOPE_AGENT); }
        { unsigned sp = 0; while (__hip_atomic_load(pf, __ATOMIC_RELAXED, __HIP_MEMORY_SCOPE_AGENT) == 0u && ++sp < (1u << 22)) __builtin_amdgcn_s_sleep(1); }
        f32x4 gv[2][2];
#pragma unroll
        for (int bj = 0; bj < 2; ++bj)
#pragma unroll
            for (int n = 0; n < 2; ++n) gv[bj][n] = *(const f32x4*)(gain + col0 + bj * HALF + 4 * n);
#pragma unroll
        for (int ai = 0; ai < 2; ++ai)
#pragma unroll
            for (int m = 0; m < 4; ++m) { const int row = row0 + ai * HALF + m * 16;
                const float r = rs_of(__hip_atomic_load(ssq + row, __ATOMIC_RELAXED, __HIP_MEMORY_SCOPE_AGENT));
#pragma unroll
                for (int bj = 0; bj < 2; ++bj) { const size_t off = (size_t)row * 1024 + col0 + bj * HALF;
                    __builtin_nontemporal_store(acc[ai][bj][m][0] * r * gv[bj][0], (f32x4*)(Out + off)); __builtin_nontemporal_store(acc[ai][bj][m][1] * r * gv[bj][1], (f32x4*)(Out + off + 4)); } }
    }
};

struct EpiTileC {
    static constexpr bool PERM = true, AFTER_DRAIN = false;
    bf16_t* O; const float* ssq; float sc; int swap;
    __device__ __forceinline__ void operator()(const f32x4 (&acc)[2][2][4][2], const Unit& u, int wr, int wc, int fr, int fq) const {
        const int tile = swap ? (u.pn * 4 + u.pm) : (u.pm * 4 + u.pn), rl0 = wr * 64 + fr, cl0 = wc * 32 + 8 * fq;
        bf16_t* base = O + (size_t)tile * 65536;
        float sv[2][4];
#pragma unroll
        for (int ai = 0; ai < 2; ++ai)
#pragma unroll
            for (int m = 0; m < 4; ++m) sv[ai][m] = ssq ? ssq[u.pm * BM + rl0 + ai * HALF + m * 16] : 0.f;
#pragma unroll
        for (int ai = 0; ai < 2; ++ai)
#pragma unroll
            for (int m = 0; m < 4; ++m) { const int rl = rl0 + ai * HALF + m * 16; const float r = (ssq ? rs_of(sv[ai][m]) : 1.f) * sc;
#pragma unroll
                for (int bj = 0; bj < 2; ++bj) *(u32x4*)(base + rl * 256 + cl0 + bj * HALF) = pack8(acc[ai][bj][m][0] * r, acc[ai][bj][m][1] * r); }
    }
};
struct EpiSoftmaxP {
    static constexpr bool PERM = true, AFTER_DRAIN = true;
    bf16_t* Pm; float* rsum;
    __device__ __forceinline__ void fused(const f32x4 (&acc)[2][2][4][2], const Unit& u, int wr, int wc, int fr, int fq, PG8_LAS unsigned char* lds, int, int) const {
        PG8_LAS float* red = (PG8_LAS float*)lds;
        const int rl0 = wr * 64 + fr, cl0 = wc * 32 + 8 * fq;
        float mx[2][4];
#pragma unroll
        for (int ai = 0; ai < 2; ++ai)
#pragma unroll
            for (int m = 0; m < 4; ++m) { float v = acc[ai][0][m][0][0];
#pragma unroll
                for (int bj = 0; bj < 2; ++bj)
#pragma unroll
                    for (int n = 0; n < 2; ++n)
#pragma unroll
                        for (int e = 0; e < 4; ++e) v = __builtin_fmaxf(v, acc[ai][bj][m][n][e]);
                v = __builtin_fmaxf(v, __shfl_xor(v, 16)); v = __builtin_fmaxf(v, __shfl_xor(v, 32));
                if (fq == 0) red[(rl0 + ai * HALF + m * 16) * 4 + wc] = v; }
        __syncthreads();
#pragma unroll
        for (int ai = 0; ai < 2; ++ai)
#pragma unroll
            for (int m = 0; m < 4; ++m) { const f32x4 t = *(const PG8_LAS f32x4*)(red + (rl0 + ai * HALF + m * 16) * 4); mx[ai][m] = __builtin_fmaxf(__builtin_fmaxf(t[0], t[1]), __builtin_fmaxf(t[2], t[3])); }
        __syncthreads();
        bf16_t* base = Pm + (size_t)u.pm * 65536;
#pragma unroll
        for (int ai = 0; ai < 2; ++ai)
#pragma unroll
            for (int m = 0; m < 4; ++m) { const int rl = rl0 + ai * HALF + m * 16; float sm = 0.f;
#pragma unroll
                for (int bj = 0; bj < 2; ++bj) { f32x4 p0, p1;
#pragma unroll
                    for (int e = 0; e < 4; ++e) { p0[e] = __builtin_amdgcn_exp2f(acc[ai][bj][m][0][e] - mx[ai][m]); p1[e] = __builtin_amdgcn_exp2f(acc[ai][bj][m][1][e] - mx[ai][m]); }
                    sm += (p0[0] + p0[1]) + (p0[2] + p0[3]) + (p1[0] + p1[1]) + (p1[2] + p1[3]);
                    *(u32x4*)(base + rl * 256 + cl0 + bj * HALF) = pack8(p0, p1); }
                sm += __shfl_xor(sm, 16); sm += __shfl_xor(sm, 32);
                if (fq == 0) red[rl * 4 + wc] = sm; }
        __syncthreads();
        if (wc == 0 && fq == 0) {
#pragma unroll
            for (int ai = 0; ai < 2; ++ai)
#pragma unroll
                for (int m = 0; m < 4; ++m) { const int rl = rl0 + ai * HALF + m * 16; const f32x4 t = *(const PG8_LAS f32x4*)(red + rl * 4); rsum[u.pm * 256 + rl] = (t[0] + t[1]) + (t[2] + t[3]); }
        }
    }
};
struct EpiO {
    static constexpr bool PERM = true, AFTER_DRAIN = false;
    bf16_t* OX; const float* rsum;
    __device__ __forceinline__ void operator()(const f32x4 (&acc)[2][2][4][2], const Unit& u, int wr, int wc, int fr, int fq) const {
        const int rl0 = wr * 64 + fr, cl0 = wc * 32 + 8 * fq, hx = u.pm & 3, row0 = (u.pm >> 2) * BM;
        float sv[2][4];
#pragma unroll
        for (int ai = 0; ai < 2; ++ai)
#pragma unroll
            for (int m = 0; m < 4; ++m) sv[ai][m] = rsum[u.pm * 256 + rl0 + ai * HALF + m * 16];
#pragma unroll
        for (int ai = 0; ai < 2; ++ai)
#pragma unroll
            for (int m = 0; m < 4; ++m) { const int rl = rl0 + ai * HALF + m * 16; const float r = __builtin_amdgcn_rcpf(sv[ai][m]);
#pragma unroll
                for (int bj = 0; bj < 2; ++bj) *(u32x4*)(OX + (size_t)(row0 + rl) * 1024 + hx * 256 + cl0 + bj * HALF) = pack8(acc[ai][bj][m][0] * r, acc[ai][bj][m][1] * r); }
    }
};
struct OrderOne {
    int tA, tB;
    __device__ __forceinline__ bool next(int i, Unit& u) const { if (i > 0) return false; u.pm = tA; u.pn = tB; u.job = 0; return true; }
    __device__ __forceinline__ const char* baseA(const Gemm& g, const Unit&) const { return (const char*)g.A; }
    __device__ __forceinline__ const char* baseB(const Gemm& g, const Unit&) const { return (const char*)g.Bt; }
    __device__ __forceinline__ void a_ready(const Unit&) const {}
    __device__ __forceinline__ void done(const Unit&) const {}
};

template <class Epi, class Sched, bool ALIGN_EPI = false, bool SP2 = false>
__device__ __forceinline__ void gemm_phase(PG8_LAS unsigned char* lds, const Gemm g, const Sched& S, const Epi& E) {
    int tid_o = threadIdx.x; asm volatile("" : "+v"(tid_o));
    const int tid = tid_o, wid = __builtin_amdgcn_readfirstlane(tid >> 6), lane = tid & 63, wr = wid >> 2, wc = wid & 3, fr = lane & 15, fq = lane >> 4;
    const int K = g.K, nt = K / BK;
    unsigned voffA[2], voffB[2];
#pragma unroll
    for (int i = 0; i < 2; ++i) { int R, C; stage_rc(tid * 16 + i * 8192, R, C); const int Rb = Epi::PERM ? ((R & ~31) + perm32(R & 31)) : R;
        voffA[i] = (unsigned)(R * K + C) * 2u; voffB[i] = (unsigned)(Rb * K + C) * 2u; }
    const size_t kstep = (size_t)(BK * 2);
    const size_t hstep = (size_t)HALF * K * 2;
    const size_t tstep = 2 * hstep;
    const unsigned ldsw = (unsigned)wid * 1024u;
    const int aoff = lds_byte(wr * 64 + fr, fq * 8), boff = lds_byte(wc * 32 + fr, fq * 8);
#define PG8_SA(b, h) (((b) * 2 + (h)) * HTB)
#define PG8_SB(b, h) ((4 + (b) * 2 + (h)) * HTB)
#define PG8_STAGE(bufoff, gbase, voff) do { _Pragma("unroll") for (int _i = 0; _i < 2; ++_i) \
        __builtin_amdgcn_global_load_lds((const unsigned*)((const char*)(gbase) + (voff)[_i]), (PG8_LAS unsigned*)(lds + (bufoff) + ldsw + _i * 8192), 16, 0, 0); } while (0)
#define PG8_LDA(dst, b, h) do { _Pragma("unroll") for (int m = 0; m < 4; ++m) _Pragma("unroll") for (int k = 0; k < 2; ++k) dst[m][k] = *(const PG8_LAS bf16x8*)(lds + PG8_SA(b, h) + aoff + m * 2048 + k * 1024); } while (0)
#define PG8_LDB(dst, b, h) do { _Pragma("unroll") for (int n = 0; n < 2; ++n) _Pragma("unroll") for (int k = 0; k < 2; ++k) dst[n][k] = *(const PG8_LAS bf16x8*)(lds + PG8_SB(b, h) + boff + n * 2048 + k * 1024); } while (0)
#define PG8_MMA(ai, bj, At, Bt) do { __builtin_amdgcn_s_setprio(1); _Pragma("unroll") for (int m = 0; m < 4; ++m) _Pragma("unroll") for (int n = 0; n < 2; ++n) _Pragma("unroll") for (int k = 0; k < 2; ++k) \
        acc[ai][bj][m][n] = __builtin_amdgcn_mfma_f32_16x16x32_bf16(Bt[n][k], At[m][k], acc[ai][bj][m][n], 0, 0, 0); __builtin_amdgcn_s_setprio(0); } while (0)
#define PG8_WAIT_V(n) asm volatile("s_waitcnt vmcnt(" #n ")" ::: "memory")
#define PG8_WAIT_L(n) asm volatile("s_waitcnt lgkmcnt(" #n ")" ::: "memory")
#define PG8_BAR __builtin_amdgcn_s_barrier()
#define PG8_SCHED __builtin_amdgcn_sched_barrier(0)
    Unit cur, nxt; int ui = 0;
    if (!S.next(0, cur)) return;
    f32x4 acc[2][2][4][2];
#pragma unroll
    for (int a = 0; a < 2; ++a)
#pragma unroll
        for (int b = 0; b < 2; ++b)
#pragma unroll
            for (int m = 0; m < 4; ++m)
#pragma unroll
                for (int n = 0; n < 2; ++n) acc[a][b][m][n] = (f32x4){0.f, 0.f, 0.f, 0.f};
    bf16x8 At[4][2], B0[2][2], B1[2][2];
    const char* cA = S.baseA(g, cur) + (size_t)cur.pm * tstep; const char* cB = S.baseB(g, cur) + (size_t)cur.pn * tstep;
    S.a_ready(cur);
    if constexpr (SP2) {
        PG8_STAGE(PG8_SB(0, 0), cB, voffB); PG8_STAGE(PG8_SB(0, 1), cB + hstep, voffB); PG8_STAGE(PG8_SA(0, 0), cA, voffA); PG8_STAGE(PG8_SA(0, 1), cA + hstep, voffA);
        if (wr == 1) PG8_BAR;
        PG8_WAIT_V(2); PG8_BAR;
        PG8_STAGE(PG8_SB(1, 0), cB + kstep, voffB); PG8_STAGE(PG8_SA(1, 0), cA + kstep, voffA); PG8_STAGE(PG8_SB(1, 1), cB + hstep + kstep, voffB);
        PG8_WAIT_V(6); PG8_BAR;
    } else {
        PG8_STAGE(PG8_SB(0, 0), cB, voffB); PG8_STAGE(PG8_SA(0, 0), cA, voffA); PG8_STAGE(PG8_SB(0, 1), cB + hstep, voffB); PG8_STAGE(PG8_SA(0, 1), cA + hstep, voffA);
        if (wr == 1) PG8_BAR;
        PG8_WAIT_V(4); PG8_BAR;
        PG8_STAGE(PG8_SB(1, 0), cB + kstep, voffB); PG8_STAGE(PG8_SA(1, 0), cA + kstep, voffA); PG8_STAGE(PG8_SB(1, 1), cB + hstep + kstep, voffB);
        PG8_WAIT_V(6); PG8_BAR;
    }
    for (;;) {
        const bool has_next = S.next(ui + 1, nxt);
        const char* nA = has_next ? S.baseA(g, nxt) + (size_t)nxt.pm * tstep : cA; const char* nB = has_next ? S.baseB(g, nxt) + (size_t)nxt.pn * tstep : cB;
        for (int t = 0; t < nt; t += 2) {
            const bool last = (t == nt - 2);
            const char* a1 = cA + (size_t)(t + 1) * kstep;
            const char* a2 = last ? nA : cA + (size_t)(t + 2) * kstep; const char* b2 = last ? nB : cB + (size_t)(t + 2) * kstep;
            const char* a3 = a2 + kstep; const char* b3 = b2 + kstep;
            if (last && has_next) S.a_ready(nxt);
            if constexpr (SP2) {
            PG8_LDB(B0, 0, 0); PG8_LDB(B1, 0, 1); PG8_SCHED; PG8_LDA(At, 0, 0); PG8_STAGE(PG8_SA(1, 1), a1 + hstep, voffA);
            PG8_WAIT_V(8); PG8_WAIT_L(0); PG8_BAR; PG8_MMA(0, 0, At, B0); PG8_MMA(0, 1, At, B1); PG8_BAR; PG8_SCHED;
            PG8_LDA(At, 0, 1); PG8_STAGE(PG8_SB(0, 0), b2, voffB); PG8_STAGE(PG8_SB(0, 1), b2 + hstep, voffB); PG8_STAGE(PG8_SA(0, 0), a2, voffA);
            PG8_WAIT_V(8); PG8_WAIT_L(0); PG8_BAR; PG8_MMA(1, 0, At, B0); PG8_MMA(1, 1, At, B1); PG8_BAR; PG8_SCHED;
            PG8_LDB(B0, 1, 0); PG8_LDB(B1, 1, 1); PG8_SCHED; PG8_LDA(At, 1, 0); PG8_STAGE(PG8_SA(0, 1), a2 + hstep, voffA);
            PG8_WAIT_V(8); PG8_WAIT_L(0); PG8_BAR; PG8_MMA(0, 0, At, B0); PG8_MMA(0, 1, At, B1); PG8_BAR; PG8_SCHED;
            PG8_LDA(At, 1, 1); PG8_STAGE(PG8_SB(1, 0), b3, voffB); PG8_STAGE(PG8_SB(1, 1), b3 + hstep, voffB); PG8_STAGE(PG8_SA(1, 0), a3, voffA);
            PG8_WAIT_V(8); PG8_WAIT_L(0); PG8_BAR; PG8_MMA(1, 0, At, B0); PG8_MMA(1, 1, At, B1); PG8_BAR; PG8_SCHED;
            } else {
            PG8_LDB(B0, 0, 0); PG8_SCHED; PG8_LDA(At, 0, 0); PG8_STAGE(PG8_SA(1, 1), a1 + hstep, voffA);
            PG8_WAIT_L(8); PG8_BAR; PG8_WAIT_L(0); PG8_MMA(0, 0, At, B0); PG8_BAR; PG8_SCHED;
            PG8_LDB(B1, 0, 1); PG8_STAGE(PG8_SB(0, 0), b2, voffB);
            PG8_BAR; PG8_WAIT_L(0); PG8_MMA(0, 1, At, B1); PG8_BAR;
            PG8_LDA(At, 0, 1); PG8_STAGE(PG8_SA(0, 0), a2, voffA);
            PG8_BAR; PG8_WAIT_L(0); PG8_MMA(1, 0, At, B0); PG8_BAR; PG8_SCHED;
            PG8_STAGE(PG8_SB(0, 1), b2 + hstep, voffB);
            PG8_WAIT_V(6); PG8_BAR; PG8_MMA(1, 1, At, B1); PG8_BAR;
            PG8_LDB(B0, 1, 0); PG8_SCHED; PG8_LDA(At, 1, 0); PG8_STAGE(PG8_SA(0, 1), a2 + hstep, voffA);
            PG8_WAIT_L(8); PG8_BAR; PG8_WAIT_L(0); PG8_MMA(0, 0, At, B0); PG8_BAR; PG8_SCHED;
            PG8_LDB(B1, 1, 1); PG8_STAGE(PG8_SB(1, 0), b3, voffB);
            PG8_BAR; PG8_WAIT_L(0); PG8_MMA(0, 1, At, B1); PG8_BAR;
            PG8_LDA(At, 1, 1); PG8_STAGE(PG8_SA(1, 0), a3, voffA);
            PG8_BAR; PG8_WAIT_L(0); PG8_MMA(1, 0, At, B0); PG8_BAR; PG8_SCHED;
            PG8_STAGE(PG8_SB(1, 1), b3 + hstep, voffB);
            PG8_WAIT_V(6); PG8_BAR; PG8_MMA(1, 1, At, B1); PG8_BAR;
            }
        }
        if constexpr (ALIGN_EPI) { if (wr == 0) PG8_BAR; }
        if constexpr (!Epi::AFTER_DRAIN) { E(acc, cur, wr, wc, fr, fq); S.done(cur); }
        if (!has_next) break;
#pragma unroll
        for (int a = 0; a < 2; ++a)
#pragma unroll
            for (int b = 0; b < 2; ++b)
#pragma unroll
                for (int m = 0; m < 4; ++m)
#pragma unroll
                    for (int n = 0; n < 2; ++n) acc[a][b][m][n] = (f32x4){0.f, 0.f, 0.f, 0.f};
        cur = nxt; cA = nA; cB = nB; ++ui;
        if constexpr (ALIGN_EPI) { if (wr == 1) PG8_BAR; }
    }
    PG8_WAIT_V(0);
    if constexpr (!ALIGN_EPI) { if (wr == 0) PG8_BAR; }
    PG8_BAR;
    if constexpr (Epi::AFTER_DRAIN) { E.fused(acc, cur, wr, wc, fr, fq, lds, wid, lane); S.done(cur); }
#undef PG8_SA
#undef PG8_SB
#undef PG8_STAGE
#undef PG8_LDA
#undef PG8_LDB
#undef PG8_MMA
#undef PG8_WAIT_V
#undef PG8_WAIT_L
#undef PG8_BAR
#undef PG8_SCHED
}
}

constexpr int NWAVES = 8, NTHREADS = NWAVES * 64;
constexpr int BATCH = 8, SEQ = 2048, DM = 1024, M = BATCH * SEQ, DFF = 2816, MEMLEN = 256, MM = BATCH * MEMLEN;
constexpr int NIN = 8192;
constexpr float QSCALE_SB = 0.08838834764831845f * 1.4426950408889634f;
constexpr float QSCALE_X = 0.0625f * 1.4426950408889634f;

constexpr size_t KiB = 1024, MiB = 1u << 20;
constexpr size_t WS_WGU = 0;
constexpr size_t WS_WD = 11 * MiB;
constexpr size_t WS_WIN = WS_WD + 5632 * KiB;
constexpr size_t WS_WCO = WS_WIN + 16 * MiB;
constexpr size_t WS_WAO = WS_WCO + 2 * MiB;
constexpr size_t WS_WO = WS_WAO + 2 * MiB;
constexpr size_t WS_WCQ = WS_WO + 2 * MiB;
constexpr size_t WS_WCKV = WS_WCQ + 2 * MiB;
constexpr size_t WS_WXO = WS_WCKV + 4 * MiB;
constexpr size_t WS_MN = WS_WXO + 2 * MiB;
constexpr size_t WS_KX = WS_MN + 4 * MiB;
constexpr size_t WS_VXT = WS_KX + 4 * MiB;
constexpr size_t WS_SSQ = WS_VXT + 4 * MiB;
constexpr size_t WS_S0 = WS_SSQ + 512 * KiB;
constexpr size_t SLOT = 32 * MiB;
constexpr size_t WS_END = WS_S0 + 6 * SLOT;
static_assert(WS_END + 32768 <= 256 * MiB, "d_ws map");

constexpr int LDS_RING = 139264, LDS_BYTES = LDS_RING + 64;
constexpr size_t WS_BAR = WS_END, BAR_BYTES = 65536;
constexpr size_t WS_RSUM = WS_BAR + BAR_BYTES;
static_assert(WS_RSUM + 262144 <= 256 * MiB, "d_ws map");
constexpr size_t WS_PANEL = WS_BAR + 32768;

#define GAS __attribute__((address_space(1)))
#define LAS __attribute__((address_space(3)))
#define DI __device__ __forceinline__
typedef unsigned short bf16;
typedef unsigned u32x4 __attribute__((ext_vector_type(4)));
typedef unsigned u32x2 __attribute__((ext_vector_type(2)));
typedef float f32x4 __attribute__((ext_vector_type(4)));
typedef float f32x16 __attribute__((ext_vector_type(16)));
typedef short bf16x8 __attribute__((ext_vector_type(8)));
#define LDS_WAIT() asm volatile("s_waitcnt lgkmcnt(0)" ::: "memory")
#define MFMA32(a, b, c) __builtin_amdgcn_mfma_f32_32x32x16_bf16((a), (b), (c), 0, 0, 0)
using pg8::cvt_pk_bf16; using pg8::pack8; using pg8::unpack8; using pg8::rs_of;

DI float wave_sum(float v) {
#pragma unroll
    for (int o = 1; o < 64; o <<= 1) v += __shfl_xor(v, o);
    return v;
}

DI void tr_load(float (&wv)[32], const float* W, int N, int k0, int n0, int lane) {
    const float* wp = W + (size_t)(k0 + (lane >> 5)) * N + n0 + (lane & 31);
#pragma unroll
    for (int i = 0; i < 32; ++i) wv[i] = __builtin_nontemporal_load(wp + (size_t)(2 * i) * N);
}
DI void tr_finish(float (&wv)[32], int K, bf16* WT, int dst_row0, const float* gain, LAS float* scr, int k0, int lane) {
    if (gain) {
#pragma unroll
        for (int i = 0; i < 32; ++i) wv[i] *= gain[k0 + 2 * i + (lane >> 5)];
    }
#pragma unroll
    for (int i = 0; i < 32; ++i) scr[(2 * i + (lane >> 5)) * 33 + (lane & 31)] = wv[i];
    LDS_WAIT(); asm volatile("" ::: "memory");
    const int c = lane & 7;
#pragma unroll
    for (int j = 0; j < 4; ++j) { const int n = (lane >> 3) + 8 * j; const LAS float* s = scr + (8 * c) * 33 + n;
        u32x4 o; o.x = cvt_pk_bf16(s[0 * 33], s[1 * 33]); o.y = cvt_pk_bf16(s[2 * 33], s[3 * 33]); o.z = cvt_pk_bf16(s[4 * 33], s[5 * 33]); o.w = cvt_pk_bf16(s[6 * 33], s[7 * 33]);
        *(u32x4*)(WT + (size_t)(dst_row0 + n) * K + k0 + 8 * c) = o; }
    LDS_WAIT(); asm volatile("" ::: "memory");
}
template <int MAP> DI int map_row(int n0) {
    if (MAP == 1) { const int j = n0 < DFF ? n0 : n0 - DFF; return (j >> 7) * 256 + (n0 < DFF ? 0 : 128) + (j & 127); }
    if (MAP == 2) { if (n0 >= 1024 && n0 < 3072) { const int j = (n0 - 1024) & 1023; return 1024 + (j >> 7) * 256 + (n0 < 2048 ? 0 : 128) + (j & 127); } return n0; }
    return n0;
}
template <int MAP> DI void convert_weight(const float* W, int K, int N, bf16* WT, const float* gain, LAS float* scr, int gw, int ngw, int lane) {
    const int nblk = N / 32, items = (K / 64) * nblk;
    int it = gw; if (it >= items) return;
    float ra[32], rb[32];
    tr_load(ra, W, N, 64 * (it / nblk), 32 * (it % nblk), lane);
    for (;;) {
        int nx = it + ngw; bool hn = nx < items;
        if (hn) tr_load(rb, W, N, 64 * (nx / nblk), 32 * (nx % nblk), lane);
        tr_finish(ra, K, WT, map_row<MAP>(32 * (it % nblk)), gain, scr, 64 * (it / nblk), lane);
        if (!hn) break;
        it = nx; nx = it + ngw; hn = nx < items;
        if (hn) tr_load(ra, W, N, 64 * (nx / nblk), 32 * (nx % nblk), lane);
        tr_finish(rb, K, WT, map_row<MAP>(32 * (it % nblk)), gain, scr, 64 * (it / nblk), lane);
        if (!hn) break;
        it = nx;
    }
}

struct CvtItem { const float* W; bf16* WT; const float* gain; int K, N, map, it; };
template <int LIST> DI bool cvt_decode(int g, const float* const* in, unsigned char* ws, CvtItem& c);
DI void cvt_load(float (&r)[32], const CvtItem& c, int lane) { const int nblk = c.N >> 5; tr_load(r, c.W, c.N, 64 * (c.it / nblk), 32 * (c.it % nblk), lane); }
DI void cvt_finish(float (&r)[32], const CvtItem& c, LAS float* scr, int lane) { const int nblk = c.N >> 5, n0 = 32 * (c.it % nblk);
    const int dst = c.map == 1 ? map_row<1>(n0) : c.map == 2 ? map_row<2>(n0) : n0; tr_finish(r, c.K, c.WT, dst, c.gain, scr, 64 * (c.it / nblk), lane); }
template <int LIST> DI void convert_list(const float* const* in, unsigned char* ws, LAS float* scr, int gw, int ngw, int lane) {
    int g = gw; CvtItem ca, cb; if (!cvt_decode<LIST>(g, in, ws, ca)) return;
    float ra[32], rb[32];
    cvt_load(ra, ca, lane);
    for (;;) {
        bool hn = cvt_decode<LIST>(g + ngw, in, ws, cb);
        if (hn) cvt_load(rb, cb, lane);
        cvt_finish(ra, ca, scr, lane);
        if (!hn) break;
        g += ngw; hn = cvt_decode<LIST>(g + ngw, in, ws, ca);
        if (hn) cvt_load(ra, ca, lane);
        cvt_finish(rb, cb, scr, lane);
        if (!hn) break;
        g += ngw;
    }
}

DI int crow(int i, int h) { return (i & 3) + 8 * (i >> 2) + 4 * h; }
constexpr int SB_KROW = 272, SB_VROW = 72, SB_KB = 32 * SB_KROW, SB_VB = 128 * SB_VROW, SB_BUF = SB_KB + SB_VB;

DI void sb_unit(LAS unsigned char* lds, bf16* Q  , const bf16* Kb, const bf16* Vt, int b, int hh, int qb, int tid, int wave, int lane) {
    const int r = lane & 31, h = lane >> 5, q0 = qb * 256;
    bf16* qp = Q + (size_t)(b * SEQ + q0 + wave * 32 + r) * 1024 + hh * 128;
    bf16x8 qf[8];
#pragma unroll
    for (int s = 0; s < 8; ++s) qf[s] = *(const bf16x8*)(qp + 16 * s + 8 * h);
    f32x16 o[4];
#pragma unroll
    for (int d = 0; d < 4; ++d)
#pragma unroll
        for (int i = 0; i < 16; ++i) o[d][i] = 0.f;
    float carry = 1.f; bool alive = true;
    volatile LAS int* fl = (volatile LAS int*)(lds + 2 * SB_BUF);
    const int nkt = (q0 + 256) / 32, dt = qb * 8 + wave;
    const int kr_ = tid >> 4, kch = tid & 15;
    const bf16* kg = Kb + (size_t)(b * SEQ + kr_) * 1024 + hh * 128 + kch * 8;
    const unsigned kl = kr_ * SB_KROW + kch * 16;
    const int vd = tid >> 2, vch = tid & 3;
    const bf16* vg = Vt + ((size_t)(b * 8 + hh) * 128 + vd) * SEQ + vch * 8;
    const unsigned vl = SB_KB + vd * SB_VROW + vch * 16;
    u32x4 kreg = *(const u32x4*)(kg + (size_t)(nkt - 1) * 32 * 1024), vreg = *(const u32x4*)(vg + (nkt - 1) * 32);
    *(LAS u32x4*)(lds + kl) = kreg; *(LAS u32x2*)(lds + vl) = (u32x2){vreg.x, vreg.y}; *(LAS u32x2*)(lds + vl + 8) = (u32x2){vreg.z, vreg.w};
    __syncthreads();
    for (int kt = nkt - 1; kt >= 0; --kt) {
        const int cur = (nkt - 1 - kt) & 1;
        LAS unsigned char* kb = lds + cur * SB_BUF; LAS unsigned char* vb = kb + SB_KB;
        if (kt > 0) { kreg = *(const u32x4*)(kg + (size_t)(kt - 1) * 32 * 1024); vreg = *(const u32x4*)(vg + (kt - 1) * 32); }
        if (kt <= dt && alive) {
            f32x16 x;
#pragma unroll
            for (int i = 0; i < 16; ++i) x[i] = 0.f;
#pragma unroll
            for (int s = 0; s < 8; ++s) { const bf16x8 a = *(const LAS bf16x8*)(kb + r * SB_KROW + (16 * s + 8 * h) * 2); x = MFMA32(a, qf[s], x); }
            float bt[16], om[16];
#pragma unroll
            for (int i = 0; i < 16; ++i) { const float e = __builtin_amdgcn_exp2f(-x[i]); const float bb = __builtin_amdgcn_rcpf(1.f + e); bt[i] = bb; om[i] = 1.f - bb; }
            if (kt == dt) {
#pragma unroll
                for (int i = 0; i < 16; ++i) { const bool valid = crow(i, h) < r; bt[i] = valid ? bt[i] : 0.f; om[i] = valid ? om[i] : 1.f; }
            }
            float G[4], PG[4];
#pragma unroll
            for (int m = 0; m < 4; ++m) { G[m] = (om[4 * m] * om[4 * m + 1]) * (om[4 * m + 2] * om[4 * m + 3]); PG[m] = __shfl_xor(G[m], 32); }
            const float T0 = G[0] * PG[0], T1 = G[1] * PG[1], T2 = G[2] * PG[2], T3 = G[3] * PG[3];
            float R[4]; R[3] = 1.f; R[2] = T3; R[1] = T3 * T2; R[0] = R[1] * T1;
            const float total = R[0] * T0;
            float p[16];
#pragma unroll
            for (int m = 0; m < 4; ++m) { float a = carry * R[m] * (h == 0 ? PG[m] : 1.f);
                p[4 * m + 3] = bt[4 * m + 3] * a; a *= om[4 * m + 3];
                p[4 * m + 2] = bt[4 * m + 2] * a; a *= om[4 * m + 2];
                p[4 * m + 1] = bt[4 * m + 1] * a; a *= om[4 * m + 1];
                p[4 * m + 0] = bt[4 * m + 0] * a; }
            carry *= total;
            alive = __builtin_amdgcn_ballot_w64(carry != 0.f) != 0ull;
            u32x4 w0, w1;
            w0.x = cvt_pk_bf16(p[0], p[1]); w0.y = cvt_pk_bf16(p[2], p[3]); w0.z = cvt_pk_bf16(p[4], p[5]); w0.w = cvt_pk_bf16(p[6], p[7]);
            w1.x = cvt_pk_bf16(p[8], p[9]); w1.y = cvt_pk_bf16(p[10], p[11]); w1.z = cvt_pk_bf16(p[12], p[13]); w1.w = cvt_pk_bf16(p[14], p[15]);
            const bf16x8 pf0 = __builtin_bit_cast(bf16x8, w0), pf1 = __builtin_bit_cast(bf16x8, w1);
#pragma unroll
            for (int db = 0; db < 4; ++db)
#pragma unroll
                for (int s = 0; s < 2; ++s) { const LAS unsigned char* vp = vb + (32 * db + r) * SB_VROW + (16 * s + 4 * h) * 2;
                    const u32x2 lo = *(const LAS u32x2*)vp, hi = *(const LAS u32x2*)(vp + 16);
                    const u32x4 av = {lo.x, lo.y, hi.x, hi.y};
                    o[db] = MFMA32(__builtin_bit_cast(bf16x8, av), s ? pf1 : pf0, o[db]); }
        }
        if (kt > 0) { LAS unsigned char* nb = lds + (cur ^ 1) * SB_BUF;
            *(LAS u32x4*)(nb + kl) = kreg; *(LAS u32x2*)(nb + vl) = (u32x2){vreg.x, vreg.y}; *(LAS u32x2*)(nb + vl + 8) = (u32x2){vreg.z, vreg.w}; }
        if (lane == 0) fl[cur * 8 + wave] = (kt <= dt && !alive) ? 1 : 0;
        __syncthreads();
        { int nd = 0;
#pragma unroll
          for (int w = 0; w < 8; ++w) nd += fl[cur * 8 + w];
          if (nd == 8) break; }
    }
#pragma unroll
    for (int db = 0; db < 4; ++db)
#pragma unroll
        for (int g = 0; g < 4; ++g) { u32x2 w; w.x = cvt_pk_bf16(o[db][4 * g], o[db][4 * g + 1]); w.y = cvt_pk_bf16(o[db][4 * g + 2], o[db][4 * g + 3]);
            *(u32x2*)(qp + 32 * db + 8 * g + 4 * h) = w; }
}

static_assert(2 * SB_BUF + 64 <= LDS_RING, "attention LDS");

#define XB_TMO      128
#define XB_XCNT(j)  (256  + 64 * (j))
#define XB_XSUB(j)  (1280 + 64 * (j))
#define XB_XGEN(j)  (2304 + 64 * (j))
#define XB_TOP      3328
#define XB_TOPGEN   3392
#define XCD_BAR_WORDS 3456
#define XB_SPIN_CAP (1u << 18)

__device__ __forceinline__ unsigned xb_ld(unsigned* p)              { return __hip_atomic_load(p, __ATOMIC_RELAXED, __HIP_MEMORY_SCOPE_AGENT); }
__device__ __forceinline__ unsigned xb_add(unsigned* p, unsigned v) { return __hip_atomic_fetch_add(p, v, __ATOMIC_RELAXED, __HIP_MEMORY_SCOPE_AGENT); }
__device__ __forceinline__ unsigned xb_xcc_id() { return (unsigned)__builtin_amdgcn_s_getreg((3 << 11) | 20) & 0xFu; }
#define XB_SPIN(cond, bar) do { unsigned _sp = 0; while (cond) { __builtin_amdgcn_s_sleep(1); \
    if ((++_sp & 255u) == 0u) { if (xb_ld(&(bar)[XB_TMO])) break; if (_sp > XB_SPIN_CAP) { atomicAdd(&(bar)[XB_TMO], 1u); break; } } } } while (0)

struct XcdBarrier {
    unsigned* bar; unsigned x;
    volatile LAS unsigned* st;
};

__device__ __forceinline__ XcdBarrier xcd_barrier_post(unsigned* bar, volatile LAS unsigned* st) {
    XcdBarrier b; b.bar = bar; b.x = xb_xcc_id(); b.st = st;
    if (threadIdx.x == 0) (void)xb_add(&bar[XB_XCNT(b.x)], 1u);
    return b;
}
__device__ __forceinline__ void xcd_barrier_complete(unsigned* bar, unsigned x, unsigned& nloc, unsigned& nx) {
    const unsigned G = gridDim.x * gridDim.y * gridDim.z;
    unsigned sum, cnt, mine, sp = 0u;
    for (;;) {
        sum = 0u; cnt = 0u; mine = 0u;
#pragma unroll
        for (unsigned j = 0; j < 16; ++j) { const unsigned c = xb_ld(&bar[XB_XCNT(j)]); sum += c; cnt += (c > 0u) ? 1u : 0u; mine = (j == x) ? c : mine; }
        if (sum == G) break;
        __builtin_amdgcn_s_sleep(1);
        if ((++sp & 255u) == 0u) { if (xb_ld(&bar[XB_TMO])) break; if (sp > XB_SPIN_CAP) { atomicAdd(&bar[XB_TMO], 1u); break; } }
    }
    nloc = mine > 0u ? mine : 1u; nx = cnt > 0u ? cnt : 1u;
}

__device__ __forceinline__ void xcd_barrier(const XcdBarrier& b) {
    asm volatile("s_waitcnt vmcnt(0)" ::: "memory");
    __syncthreads();
    if (threadIdx.x == 0) {
        unsigned* bar = b.bar;
        __builtin_amdgcn_s_waitcnt(0);
        unsigned nloc = b.st[0], nx = b.st[1];
        if (nloc == 0u) { xcd_barrier_complete(bar, b.x, nloc, nx); b.st[0] = nloc; b.st[1] = nx; }
        const unsigned old = xb_add(&bar[XB_XSUB(b.x)], 1u);
        const unsigned gen = old / nloc;
        if (old + 1u == (gen + 1u) * nloc) {
            __builtin_amdgcn_fence(__ATOMIC_RELEASE, "agent");
            asm volatile("s_waitcnt vmcnt(0)" ::: "memory");
            const unsigned og = xb_add(&bar[XB_TOP], 1u);
            const unsigned tg = og / nx;
            if (og + 1u == (tg + 1u) * nx) xb_add(&bar[XB_TOPGEN], 1u);
            else XB_SPIN(xb_ld(&bar[XB_TOPGEN]) == tg, bar);
            __builtin_amdgcn_fence(__ATOMIC_ACQUIRE, "agent");
            xb_add(&bar[XB_XGEN(b.x)], 1u);
            asm volatile("s_waitcnt vmcnt(0)" ::: "memory");
        } else {
            XB_SPIN(xb_ld(&bar[XB_XGEN(b.x)]) == gen, bar);
            __builtin_amdgcn_fence(__ATOMIC_ACQUIRE, "agent");
            asm volatile("s_waitcnt vmcnt(0)" ::: "memory");
        }
    }
    __syncthreads();
}

#define XL_SUB(j) (5120 + 64 * (j))
#define XL_GEN(j) (6144 + 64 * (j))
#define XL_BAD 7168
__device__ __forceinline__ void xcd_local_barrier(const XcdBarrier& b) {
    asm volatile("s_waitcnt vmcnt(0)" ::: "memory");
    __syncthreads();
    if (threadIdx.x == 0) {
        unsigned* bar = b.bar;
        __builtin_amdgcn_s_waitcnt(0);
        const unsigned nloc = b.st[0];
        const unsigned old = xb_add(&bar[XL_SUB(b.x)], 1u);
        const unsigned gen = old / nloc;
        if (old + 1u == (gen + 1u) * nloc) xb_add(&bar[XL_GEN(b.x)], 1u);
        else XB_SPIN(xb_ld(&bar[XL_GEN(b.x)]) == gen, bar);
        __builtin_amdgcn_fence(__ATOMIC_ACQUIRE, "agent");
        asm volatile("s_waitcnt vmcnt(0)" ::: "memory");
    }
    __syncthreads();
}

struct Order1 { pg8::StaticOrder Sa, Sk, Sv; unsigned char* ws; int na;
    DI void init(unsigned char* ws_, int G, int c) { ws = ws_; Sa.init(M, 2 * DFF, G, c); Sk.init(MM, DM, G, (c + 128) % G); Sv.init(DM, MM, G, (c + 96) % G); const int nu = (M / 256) * (2 * DFF / 256); na = c < nu ? (nu - c + G - 1) / G : 0; }
    DI bool next(int i, pg8::Unit& u) const { if (Sa.next(i, u)) return true; if (i == na) { if (Sk.next(0, u)) { u.job = 1; return true; } if (Sv.next(0, u)) { u.job = 2; return true; } } return false; }
    DI const char* baseA(const pg8::Gemm&, const pg8::Unit& u) const { return (const char*)ws + (u.job == 0 ? WS_S0 : u.job == 1 ? WS_MN : WS_WCKV + (size_t)DM * DM * 2); }
    DI const char* baseB(const pg8::Gemm&, const pg8::Unit& u) const { return (const char*)ws + (u.job == 0 ? WS_WGU : u.job == 1 ? WS_WCKV : WS_MN); }
    DI void a_ready(const pg8::Unit&) const {} DI void done(const pg8::Unit&) const {}
};
struct Epi1 { static constexpr bool PERM = true, AFTER_DRAIN = false; unsigned char* ws;
    DI void operator()(const pg8::f32x4 (&acc)[2][2][4][2], const pg8::Unit& u, int wr, int wc, int fr, int fq) const {
        if (u.job == 0) { pg8::EpiSwiGLU e{(pg8::bf16_t*)(ws + WS_S0 + SLOT), (const float*)(ws + WS_SSQ), DFF}; e(acc, u, wr, wc, fr, fq); }
        else if (u.job == 1) { pg8::EpiTileC e{(pg8::bf16_t*)(ws + WS_KX), nullptr, 1.f, 0}; e(acc, u, wr, wc, fr, fq); }
        else { pg8::EpiTileC e{(pg8::bf16_t*)(ws + WS_VXT), nullptr, 1.f, 1}; e(acc, u, wr, wc, fr, fq); }
    }
};
struct Order3 { pg8::StaticOrder Sa, Sv; unsigned char* ws;
    DI void init(unsigned char* ws_, int G, int c) { ws = ws_; Sa.init(M, 5120, G, c); Sv.init(DM, M, G, c); }
    DI bool next(int i, pg8::Unit& u) const { if (Sa.next(i, u)) return true; const int na = (1280 - Sa.c + Sa.G - 1) / Sa.G; if (Sv.next(i - na, u)) { u.job = 1; return true; } return false; }
    DI const char* baseA(const pg8::Gemm&, const pg8::Unit& u) const { return (const char*)ws + (u.job == 0 ? WS_S0 : WS_WIN + (size_t)5120 * DM * 2); }
    DI const char* baseB(const pg8::Gemm&, const pg8::Unit& u) const { return (const char*)ws + (u.job == 0 ? WS_WIN : WS_S0); }
    DI void a_ready(const pg8::Unit&) const {} DI void done(const pg8::Unit&) const {}
};
struct Epi3 { static constexpr bool PERM = true, AFTER_DRAIN = false; unsigned char* ws;
    DI void operator()(const pg8::f32x4 (&acc)[2][2][4][2], const pg8::Unit& u, int wr, int wc, int fr, int fq) const {
        const float* ssq1 = (const float*)(ws + WS_SSQ) + M;
        if (u.job == 0) { pg8::EpiMixIn e{(pg8::bf16_t*)(ws + WS_S0 + SLOT), (pg8::bf16_t*)(ws + WS_S0 + 2 * SLOT), (pg8::bf16_t*)(ws + WS_S0 + 3 * SLOT), (pg8::bf16_t*)(ws + WS_S0 + 4 * SLOT), ssq1, QSCALE_SB}; e(acc, u, wr, wc, fr, fq); }
        else { pg8::EpiVt e{(pg8::bf16_t*)(ws + WS_S0 + 5 * SLOT), ssq1}; e(acc, u, wr, wc, fr, fq); }
    }
};
struct Order5 { pg8::StaticOrder S; unsigned char* ws;
    DI void init(unsigned char* ws_, int G, int c) { ws = ws_; S.init(M, DM, G, c); }
    DI bool next(int i, pg8::Unit& u) const { if (i >= 4) return false; if (!S.next(0, u)) return false; u.job = i; return true; }
    DI const char* baseA(const pg8::Gemm&, const pg8::Unit& u) const { return (const char*)ws + (u.job == 1 ? WS_S0 + SLOT : u.job == 3 ? WS_S0 + 3 * SLOT : WS_S0); }
    DI const char* baseB(const pg8::Gemm&, const pg8::Unit& u) const { return (const char*)ws + (u.job == 0 ? WS_WIN + (size_t)6144 * DM * 2 : u.job == 1 ? WS_WCO : u.job == 2 ? WS_WIN + (size_t)7168 * DM * 2 : WS_WAO); }
    DI void a_ready(const pg8::Unit&) const {} DI void done(const pg8::Unit&) const {}
};
struct Epi5 { static constexpr bool PERM = true, AFTER_DRAIN = false; unsigned char* ws; const float* bgate;
    DI void operator()(const pg8::f32x4 (&acc)[2][2][4][2], const pg8::Unit& u, int wr, int wc, int fr, int fq) const {
        const float* ssq1 = (const float*)(ws + WS_SSQ) + M; pg8::bf16_t* S4 = (pg8::bf16_t*)(ws + WS_S0 + 4 * SLOT); pg8::bf16_t* S5 = (pg8::bf16_t*)(ws + WS_S0 + 5 * SLOT);
        if (u.job == 0) { pg8::EpiGen<1> e{S4, DM, ssq1, 1.f, bgate}; e(acc, u, wr, wc, fr, fq); }
        else if (u.job == 1) { pg8::EpiGateMul<0> e{S4, nullptr}; e(acc, u, wr, wc, fr, fq); }
        else if (u.job == 2) { pg8::EpiGen<1> e{S5, DM, ssq1, 1.f, bgate + DM}; e(acc, u, wr, wc, fr, fq); }
        else { pg8::EpiGateMul<1> e{S5, S4}; e(acc, u, wr, wc, fr, fq); }
    }
};
#define GEMM_MULTI(OrderT, EpiT, Kv, ...) do { pg8::Gemm g_{nullptr, nullptr, 0, 0, (Kv)}; OrderT S_; S_.init(ws, G, c); EpiT E_{__VA_ARGS__}; pg8::gemm_phase<EpiT, OrderT, true, true>(lds, g_, S_, E_); } while (0)

struct Params { const float* in[21]; float* out; unsigned char* ws; };
enum { I_X = 0, I_MEM, I_G_FFN1, I_W_FFN1_GU, I_W_FFN1_DOWN, I_G_MIX, I_W_IN, I_B_GATE, I_CONV_W, I_W_CONV_OUT, I_W_ATTN_OUT, I_W_O, I_G_CROSS, I_G_MEM, I_W_CQ, I_W_CKV, I_W_CO,
       I_G_FFN2, I_W_FFN2_GU, I_W_FFN2_DOWN, I_G_FINAL };

template <> DI bool cvt_decode<0>(int g, const float* const* in, unsigned char* ws, CvtItem& c) {
    if (g >= 7808) return false;
    if (g < 2816) { c.W = in[I_W_FFN1_GU]; c.WT = (bf16*)(ws + WS_WGU); c.gain = in[I_G_FFN1]; c.K = DM; c.N = 2 * DFF; c.map = 1; c.it = g; }
    else if (g < 3840) { c.W = in[I_W_CKV]; c.WT = (bf16*)(ws + WS_WCKV); c.gain = nullptr; c.K = DM; c.N = 2 * DM; c.map = 0; c.it = g - 2816; }
    else if (g < 5248) { c.W = in[I_W_FFN1_DOWN]; c.WT = (bf16*)(ws + WS_WD); c.gain = nullptr; c.K = DFF; c.N = DM; c.map = 0; c.it = g - 3840; }
    else { const int j = (g - 5248) >> 9; c.it = (g - 5248) & 511; c.K = DM; c.N = DM; c.map = 0;
        c.W = in[j == 0 ? I_W_CONV_OUT : j == 1 ? I_W_ATTN_OUT : j == 2 ? I_W_O : j == 3 ? I_W_CQ : I_W_CO];
        c.WT = (bf16*)(ws + (j == 0 ? WS_WCO : j == 1 ? WS_WAO : j == 2 ? WS_WO : j == 3 ? WS_WCQ : WS_WXO));
        c.gain = j == 3 ? in[I_G_CROSS] : nullptr; }
    return true;
}
template <> DI bool cvt_decode<1>(int g, const float* const* in, unsigned char* ws, CvtItem& c) {
    if (g >= 4224) return false;
    if (g < 2816) { c.W = in[I_W_FFN2_GU]; c.WT = (bf16*)(ws + WS_WGU); c.gain = in[I_G_FFN2]; c.K = DM; c.N = 2 * DFF; c.map = 1; c.it = g; }
    else { c.W = in[I_W_FFN2_DOWN]; c.WT = (bf16*)(ws + WS_WD); c.gain = nullptr; c.K = DFF; c.N = DM; c.map = 0; c.it = g - 2816; }
    return true;
}

#define GEMM(EpiT, Aptr, Bptr, Mv, Nv, Kv, cid, ...) do { pg8::Gemm g_{(const pg8::bf16_t*)(Aptr), (const pg8::bf16_t*)(Bptr), (Mv), (Nv), (Kv)}; pg8::StaticOrder S_; S_.init((Mv), (Nv), G, (cid)); \
        EpiT E_{__VA_ARGS__}; pg8::gemm_phase<EpiT, pg8::StaticOrder, true, true>(lds, g_, S_, E_); } while (0)

__global__ void __launch_bounds__(NTHREADS, 2) fwd_megakernel(Params P) {
    extern __shared__ __attribute__((aligned(16))) unsigned char lds_raw[];
    LAS unsigned char* lds = (LAS unsigned char*)lds_raw;
    cg::grid_group grid = cg::this_grid();
    const int tid = threadIdx.x, lane = tid & 63, wave = __builtin_amdgcn_readfirstlane(tid >> 6);
    const int G = gridDim.x, c = blockIdx.x;
    const int gw = c * NWAVES + wave, ngw = G * NWAVES;
    unsigned char* ws = P.ws;
    bf16* WGU = (bf16*)(ws + WS_WGU); bf16* WD = (bf16*)(ws + WS_WD); bf16* WIN = (bf16*)(ws + WS_WIN);
    bf16* WCO = (bf16*)(ws + WS_WCO); bf16* WAO = (bf16*)(ws + WS_WAO); bf16* WO = (bf16*)(ws + WS_WO); bf16* WCQ = (bf16*)(ws + WS_WCQ);
    bf16* WCKV = (bf16*)(ws + WS_WCKV); bf16* WXO = (bf16*)(ws + WS_WXO);
    bf16* MN = (bf16*)(ws + WS_MN); bf16* KX = (bf16*)(ws + WS_KX); bf16* VXT = (bf16*)(ws + WS_VXT);
    float* SSQ = (float*)(ws + WS_SSQ);
    float *ssq0 = SSQ, *ssq1 = SSQ + M, *ssq2 = SSQ + 2 * M, *ssq3 = SSQ + 3 * M, *ssq4 = SSQ + 4 * M;
    bf16* S0 = (bf16*)(ws + WS_S0); bf16* S1 = (bf16*)(ws + WS_S0 + SLOT); bf16* S2 = (bf16*)(ws + WS_S0 + 2 * SLOT); bf16* S3 = (bf16*)(ws + WS_S0 + 3 * SLOT);
    bf16* S4 = (bf16*)(ws + WS_S0 + 4 * SLOT); bf16* S5 = (bf16*)(ws + WS_S0 + 5 * SLOT);
    LAS float* scr = (LAS float*)(lds + wave * 16384);
    volatile LAS unsigned* bst = (volatile LAS unsigned*)(lds + LDS_RING);
    if (tid < 16) bst[tid] = 0u;
    __syncthreads();
    const XcdBarrier xbar = xcd_barrier_post((unsigned*)(ws + WS_BAR), bst);
    if (tid == 0) (void)__hip_atomic_fetch_or((unsigned*)(ws + WS_BAR) + XL_BAD + (c & 7), (1u << xb_xcc_id()) | (G != 256 ? 0x80000000u : 0u), __ATOMIC_RELAXED, __HIP_MEMORY_SCOPE_AGENT);

    {
        convert_list<0>(P.in, ws, scr, gw, ngw, lane);
        for (int m0 = 4 * gw; m0 < M; m0 += 4 * ngw) {
            f32x4 v[4][4];
#pragma unroll
            for (int q = 0; q < 4; ++q)
#pragma unroll
                for (int j = 0; j < 4; ++j) v[q][j] = __builtin_nontemporal_load((const f32x4*)(P.in[I_X] + (size_t)(m0 + q) * DM) + lane + 64 * j);
#pragma unroll
            for (int q = 0; q < 4; ++q) { unsigned long long* o8 = (unsigned long long*)(S0 + (size_t)(m0 + q) * DM) + lane; float s = 0.f;
#pragma unroll
                for (int j = 0; j < 4; ++j) { const f32x4 t = v[q][j]; s += (t.x * t.x + t.y * t.y) + (t.z * t.z + t.w * t.w);
                    o8[64 * j] = (unsigned long long)cvt_pk_bf16(t.x, t.y) | ((unsigned long long)cvt_pk_bf16(t.z, t.w) << 32); }
                s = wave_sum(s); if (lane == 0) ssq0[m0 + q] = s; }
        }
        for (int m = gw; m < MM; m += ngw) {
            const f32x4* xr = (const f32x4*)(P.in[I_MEM] + (size_t)m * DM) + lane; const f32x4* gr = (const f32x4*)P.in[I_G_MEM] + lane;
            unsigned long long* o8 = (unsigned long long*)(MN + (size_t)m * DM) + lane; f32x4 v[4]; float s = 0.f;
#pragma unroll
            for (int j = 0; j < 4; ++j) { v[j] = xr[64 * j]; s += (v[j].x * v[j].x + v[j].y * v[j].y) + (v[j].z * v[j].z + v[j].w * v[j].w); }
            const float rs = rs_of(wave_sum(s));
#pragma unroll
            for (int j = 0; j < 4; ++j) { const f32x4 g = gr[64 * j]; const f32x4 y = v[j] * rs * g;
                o8[64 * j] = (unsigned long long)cvt_pk_bf16(y.x, y.y) | ((unsigned long long)cvt_pk_bf16(y.z, y.w) << 32); }
        }
        for (int i = c * NTHREADS + tid; i < 4 * M; i += G * NTHREADS) ssq1[i] = 0.f;
    }
    if (P.ws == nullptr) grid.sync();
    xcd_barrier(xbar);
    bool fastb;
    {
        if (tid == 0) { unsigned un = 0u; bool one = true;
#pragma unroll
            for (int j = 0; j < 8; ++j) { const unsigned m = xb_ld((unsigned*)(ws + WS_BAR) + XL_BAD + j); one = one && (__builtin_popcount(m) == 1); un |= m; }
            bst[4] = (one && __builtin_popcount(un) == 8 && (un >> 16) == 0u) ? 1u : 0u; }
        __syncthreads();
        fastb = __builtin_amdgcn_readfirstlane((int)bst[4]) != 0; }
#define SEAM_LOCAL() do { if (fastb) xcd_local_barrier(xbar); else xcd_barrier(xbar); } while (0)

    GEMM_MULTI(Order1, Epi1, DM, ws);
    if (G != 256 || c >= 192) {
        const int gw2 = G == 256 ? (c - 192) * NWAVES + wave : gw, ngw2 = G == 256 ? 64 * NWAVES : ngw;
        convert_weight<2>(P.in[I_W_IN], DM, NIN, WIN, P.in[I_G_MIX], scr, gw2, ngw2, lane);
    }
    SEAM_LOCAL();

    GEMM(pg8::EpiResid, S1, WD, M, DM, DFF, c, (pg8::bf16_t*)S0, ssq1, 0.5f);
    xcd_barrier(xbar);

    GEMM_MULTI(Order3, Epi3, DM, ws);
    SEAM_LOCAL();

    {
        convert_list<1>(P.in, ws, scr, gw, ngw, lane);
        const float* cw = P.in[I_CONV_W];
        const int nbb = (G & 7) == 0 ? G >> 3 : 0;
        for (int idx = (nbb ? (c >> 3) : c) * NTHREADS + tid; idx < (nbb ? SEQ * 64 : M * 64); idx += (nbb ? nbb : G) * NTHREADS) {
            const int t = (idx >> 7) * 2 + (nbb ? (c & 7) * SEQ : 0), c8 = (idx & 127) * 8, s = t & (SEQ - 1); const size_t off = (size_t)t * 1024 + c8;
            const u32x4 z4 = {0u, 0u, 0u, 0u};
            const u32x4 r1 = *(const u32x4*)(S2 + off + 1024), r0 = *(const u32x4*)(S2 + off), rm1 = s >= 1 ? *(const u32x4*)(S2 + off - 1024) : z4, rm2 = s >= 2 ? *(const u32x4*)(S2 + off - 2048) : z4;
            const u32x4 cbr0 = *(const u32x4*)(S1 + off), cbr1 = *(const u32x4*)(S1 + off + 1024);
            f32x4 a0, a1, b0, b1, e0, e1, g0, g1, cb0, cb1, cc0, cc1;
            unpack8(r1, g0, g1); unpack8(r0, a0, a1); unpack8(rm1, b0, b1); unpack8(rm2, e0, e1); unpack8(cbr0, cb0, cb1); unpack8(cbr1, cc0, cc1);
            const f32x4 w00 = *(const f32x4*)(cw + c8), w01 = *(const f32x4*)(cw + c8 + 4), w10 = *(const f32x4*)(cw + 1024 + c8), w11 = *(const f32x4*)(cw + 1024 + c8 + 4),
                        w20 = *(const f32x4*)(cw + 2048 + c8), w21 = *(const f32x4*)(cw + 2048 + c8 + 4);
            *(u32x4*)(S1 + off) = pack8(cb0 * (w00 * e0 + w10 * b0 + w20 * a0), cb1 * (w01 * e1 + w11 * b1 + w21 * a1));
            *(u32x4*)(S1 + off + 1024) = pack8(cc0 * (w00 * b0 + w10 * a0 + w20 * g0), cc1 * (w01 * b1 + w11 * a1 + w21 * g1));
        }
        __syncthreads();
        if (nbb) { for (int j = c >> 3; j < 32; j += nbb) { const int b = c & 7, hh = j >> 2, pr = j & 3;
            sb_unit(lds, S3, S4, S5, b, hh, 7 - pr, tid, wave, lane);
            sb_unit(lds, S3, S4, S5, b, hh, pr, tid, wave, lane); } }
        else for (int u = c; u < 256; u += G) { const int bh = u >> 2, pr = u & 3;
            sb_unit(lds, S3, S4, S5, bh >> 3, bh & 7, 7 - pr, tid, wave, lane);
            sb_unit(lds, S3, S4, S5, bh >> 3, bh & 7, pr, tid, wave, lane); }
    }
    xcd_barrier(xbar);

    GEMM_MULTI(Order5, Epi5, DM, ws, P.in[I_B_GATE]);
    SEAM_LOCAL();

    GEMM(pg8::EpiResid, S5, WO, M, DM, DM, c, (pg8::bf16_t*)S0, ssq2, 1.f);
    SEAM_LOCAL();

    GEMM(pg8::EpiTileC, S0, WCQ, M, DM, DM, c, (pg8::bf16_t*)S1, ssq2, QSCALE_X, 0);
    {
#define SYNC_OWN() do { asm volatile("s_waitcnt vmcnt(0)" ::: "memory"); __syncthreads(); if (tid == 0) { __builtin_amdgcn_fence(__ATOMIC_ACQUIRE, "agent"); asm volatile("s_waitcnt vmcnt(0)" ::: "memory"); } __syncthreads(); } while (0)
        float* RS = (float*)(ws + WS_RSUM);
        pg8::StaticOrder So; So.init(M, DM, G, c);
        for (int i = 0;; ++i) { pg8::Unit u0; if (!So.next(i, u0)) break;
            const int tA = u0.pm * 4 + u0.pn, tB = (u0.pm >> 3) * 4 + u0.pn;
            SYNC_OWN();
            { pg8::Gemm g_{(const pg8::bf16_t*)S1, (const pg8::bf16_t*)KX, 0, 0, 256}; pg8::OrderOne S_{tA, tB}; pg8::EpiSoftmaxP E_{(pg8::bf16_t*)S3, RS};
              pg8::gemm_phase<pg8::EpiSoftmaxP, pg8::OrderOne, false, true>(lds, g_, S_, E_); }
            SYNC_OWN();
            { pg8::Gemm g_{(const pg8::bf16_t*)S3, (const pg8::bf16_t*)VXT, 0, 0, 256}; pg8::OrderOne S_{tA, tB}; pg8::EpiO E_{(pg8::bf16_t*)S2, RS};
              pg8::gemm_phase<pg8::EpiO, pg8::OrderOne, true, true>(lds, g_, S_, E_); }
        }
    }
    SEAM_LOCAL();

    GEMM(pg8::EpiResid, S2, WXO, M, DM, DM, c, (pg8::bf16_t*)S0, ssq3, 1.f);
    SEAM_LOCAL();

    GEMM(pg8::EpiSwiGLU, S0, WGU, M, 2 * DFF, DM, c, (pg8::bf16_t*)S1, ssq3, DFF);
    SEAM_LOCAL();

    GEMM(pg8::EpiFinal, S1, WD, M, DM, DFF, c, (const pg8::bf16_t*)S0, P.out, ssq4, 0.5f, P.in[I_G_FINAL], (unsigned*)(ws + WS_PANEL));
}

extern "C" void kernel_launch(void* const* d_in, const int* in_sizes, int n_in, void* d_out, int out_size, void* d_ws, size_t ws_size, hipStream_t stream) {
    static int grid_blocks = 0;
    if (grid_blocks == 0) {
        if (n_in != 21 || out_size != M * DM || ws_size < WS_END) { fprintf(stderr, "kernel_launch: unexpected problem (n_in %d, out %d, ws %zu)\n", n_in, out_size, ws_size); grid_blocks = -1; return; }
        int dev = 0, cus = 0, per_cu = 0;
        (void)hipGetDevice(&dev);
        (void)hipDeviceGetAttribute(&cus, hipDeviceAttributeMultiprocessorCount, dev);
        if (hipFuncSetAttribute((const void*)fwd_megakernel, hipFuncAttributeMaxDynamicSharedMemorySize, LDS_BYTES) != hipSuccess) { fprintf(stderr, "kernel_launch: hipFuncSetAttribute failed\n"); grid_blocks = -1; return; }
        if (hipOccupancyMaxActiveBlocksPerMultiprocessor(&per_cu, (const void*)fwd_megakernel, NTHREADS, LDS_BYTES) != hipSuccess || per_cu < 1) { fprintf(stderr, "kernel_launch: occupancy query failed (%d)\n", per_cu); (void)hipGetLastError(); grid_blocks = -1; return; }
        grid_blocks = cus * per_cu;
    }
    if (grid_blocks < 0) return;
    if (hipMemsetAsync((unsigned char*)d_ws + WS_BAR, 0, BAR_BYTES, stream) != hipSuccess) { fprintf(stderr, "kernel_launch: memset failed\n"); return; }
    Params p{};
    for (int i = 0; i < 21; ++i) p.in[i] = (const float*)d_in[i];
    p.out = (float*)d_out; p.ws = (unsigned char*)d_ws;
    void* args[] = {&p};
    hipError_t e = hipLaunchCooperativeKernel((const void*)fwd_megakernel, dim3(grid_blocks), dim3(NTHREADS), args, LDS_BYTES, stream);
    if (e != hipSuccess) fprintf(stderr, "cooperative launch failed: %s (grid %d)\n", hipGetErrorString(e), grid_blocks);
}
```

```cpp
#include <hip/hip_runtime.h>
#include <hip/hip_cooperative_groups.h>
#include <cstdio>
#include <cstdint>
namespace cg = cooperative_groups;
namespace pg8 {
#define PG8_LAS __attribute__((address_space(3)))
typedef unsigned short bf16_t;
typedef short bf16x8 __attribute__((ext_vector_type(8)));
typedef float f32x4 __attribute__((ext_vector_type(4)));
typedef unsigned u32x4 __attribute__((ext_vector_type(4)));
constexpr int BM = 256, BK = 64, HALF = 128, HTB = HALF * BK * 2  , STAGE_BYTES = 8 * HTB, NXCD = 8, WGM = 8;

__host__ __device__ __forceinline__ int lds_byte(int r, int c) { const int st = (r >> 4) * 2 + (c >> 5), rr = r & 15, cc = c & 31, ob = rr * 64 + cc * 2; return st * 1024 + (ob ^ (((ob >> 9) & 1) << 5)); }
__host__ __device__ __forceinline__ void stage_rc(int b, int& R, int& C) { const int st = b / 1024, sb = b % 1024, swz = sb ^ (((sb >> 9) & 1) << 5); R = (st >> 1) * 16 + swz / 64; C = (st & 1) * 32 + (swz % 64) / 2; }
__host__ __device__ __forceinline__ int perm32(int rho) { const int n = rho >> 4, i = rho & 15; return 8 * (i >> 2) + 4 * n + (i & 3); }

struct Unit { int pm, pn, job; };
struct Gemm { const bf16_t* A; const bf16_t* Bt; int M, N, K; };

struct StaticOrder {
    int nM, nN, nwg, G, c;
    __host__ __device__ void init(int M, int N, int G_, int c_) { nM = M / BM; nN = N / BM; nwg = nM * nN; G = G_; c = c_; }
    __host__ __device__ bool next(int i, Unit& u) const {
        const long L = (long)i * G + c; if (L >= nwg) return false;
        int wgid = (int)L; { const int q = nwg / NXCD, r = nwg % NXCD, xcd = wgid % NXCD, off = wgid / NXCD; wgid = (xcd < r ? xcd * (q + 1) : r * (q + 1) + (xcd - r) * q) + off; }
        const int nig = WGM * nN, gid = wgid / nig, fm = gid * WGM, gsz = (nM - fm) < WGM ? (nM - fm) : WGM;
        u.pm = fm + ((wgid % nig) % gsz); u.pn = (wgid % nig) / gsz; u.job = 0; return true;
    }
    __device__ __forceinline__ const char* baseA(const Gemm& g, const Unit&) const { return (const char*)g.A; }
    __device__ __forceinline__ const char* baseB(const Gemm& g, const Unit&) const { return (const char*)g.Bt; }
    __device__ __forceinline__ void a_ready(const Unit&) const {}
    __device__ __forceinline__ void done(const Unit&) const {}
};

typedef __bf16 bf16x2_t __attribute__((ext_vector_type(2)));
typedef float f32x2_t __attribute__((ext_vector_type(2)));
__device__ __forceinline__ unsigned cvt_pk_bf16(float lo, float hi) { f32x2_t v = {lo, hi}; bf16x2_t b = __builtin_convertvector(v, bf16x2_t); return __builtin_bit_cast(unsigned, b); }
__device__ __forceinline__ u32x4 pack8(f32x4 a, f32x4 b) { u32x4 w; w.x = cvt_pk_bf16(a[0], a[1]); w.y = cvt_pk_bf16(a[2], a[3]); w.z = cvt_pk_bf16(b[0], b[1]); w.w = cvt_pk_bf16(b[2], b[3]); return w; }
__device__ __forceinline__ float bf_lo(unsigned w) { return __builtin_bit_cast(float, w << 16); }
__device__ __forceinline__ float bf_hi(unsigned w) { return __builtin_bit_cast(float, w & 0xffff0000u); }
__device__ __forceinline__ void unpack8(u32x4 w, f32x4& a, f32x4& b) { a = (f32x4){bf_lo(w.x), bf_hi(w.x), bf_lo(w.y), bf_hi(w.y)}; b = (f32x4){bf_lo(w.z), bf_hi(w.z), bf_lo(w.w), bf_hi(w.w)}; }
constexpr float RMS_EPS_F = 1e-6f;
__device__ __forceinline__ float rs_of(float ssq) { return __builtin_amdgcn_rsqf(ssq * (1.f / 1024.f) + RMS_EPS_F); }
__device__ __forceinline__ float sigmoid_f(float v) { return __builtin_amdgcn_rcpf(1.f + __builtin_amdgcn_exp2f(-1.4426950408889634f * v)); }

struct EpiSwiGLU {
    static constexpr bool PERM = true, AFTER_DRAIN = false;
    bf16_t* O; const float* ssq; int ldo;
    __device__ __forceinline__ void operator()(const f32x4 (&acc)[2][2][4][2], const Unit& u, int wr, int wc, int fr, int fq) const {
        const int row0 = u.pm * BM + wr * 64 + fr, col0 = u.pn * HALF + wc * 32 + 8 * fq;
        float sv[2][4];
#pragma unroll
        for (int ai = 0; ai < 2; ++ai)
#pragma unroll
            for (int m = 0; m < 4; ++m) sv[ai][m] = ssq[row0 + ai * HALF + m * 16];
#pragma unroll
        for (int ai = 0; ai < 2; ++ai)
#pragma unroll
            for (int m = 0; m < 4; ++m) { const int row = row0 + ai * HALF + m * 16; const float r = rs_of(sv[ai][m]);
                f32x4 o[2];
#pragma unroll
                for (int n = 0; n < 2; ++n) { const f32x4 g = acc[ai][0][m][n] * r, up = acc[ai][1][m][n] * r;
#pragma unroll
                    for (int e = 0; e < 4; ++e) o[n][e] = g[e] * sigmoid_f(g[e]) * up[e]; }
                *(u32x4*)(O + (size_t)row * ldo + col0) = pack8(o[0], o[1]); }
    }
};

struct EpiResid {
    static constexpr bool PERM = true, AFTER_DRAIN = false;
    bf16_t* HB; float* ssq; float alpha;
    __device__ __forceinline__ void operator()(const f32x4 (&acc)[2][2][4][2], const Unit& u, int wr, int wc, int fr, int fq) const {
        const int row0 = u.pm * BM + wr * 64 + fr, col0 = u.pn * BM + wc * 32 + 8 * fq;
#pragma unroll
        for (int ai = 0; ai < 2; ++ai)
#pragma unroll
            for (int m = 0; m < 4; ++m) { const int row = row0 + ai * HALF + m * 16; float ss = 0.f;
#pragma unroll
                for (int bj = 0; bj < 2; ++bj) { const size_t off = (size_t)row * 1024 + col0 + bj * HALF;
                    f32x4 a, b; unpack8(*(const u32x4*)(HB + off), a, b);
                    a = a + acc[ai][bj][m][0] * alpha; b = b + acc[ai][bj][m][1] * alpha;
                    *(u32x4*)(HB + off) = pack8(a, b);
                    ss += (a[0] * a[0] + a[1] * a[1]) + (a[2] * a[2] + a[3] * a[3]) + (b[0] * b[0] + b[1] * b[1]) + (b[2] * b[2] + b[3] * b[3]); }
                ss += __shfl_xor(ss, 16); ss += __shfl_xor(ss, 32);
                if (fq == 0) unsafeAtomicAdd(ssq + row, ss); }
    }
};

struct EpiMixIn {
    static constexpr bool PERM = true, AFTER_DRAIN = false;
    bf16_t *CB, *CCX, *Q, *Kb; const float* ssq; float qscale;
    __device__ __forceinline__ void operator()(const f32x4 (&acc)[2][2][4][2], const Unit& u, int wr, int wc, int fr, int fq) const {
        const int row0 = u.pm * BM + wr * 64 + fr, pn = u.pn;
        float sv[2][4];
#pragma unroll
        for (int ai = 0; ai < 2; ++ai)
#pragma unroll
            for (int m = 0; m < 4; ++m) sv[ai][m] = ssq[row0 + ai * HALF + m * 16];
        if (pn >= 4 && pn < 12) {
            const int col0 = (pn - 4) * HALF + wc * 32 + 8 * fq;
#pragma unroll
            for (int ai = 0; ai < 2; ++ai)
#pragma unroll
                for (int m = 0; m < 4; ++m) { const int row = row0 + ai * HALF + m * 16; const float r = rs_of(sv[ai][m]), r2 = r * r;
                    *(u32x4*)(CCX + (size_t)row * 1024 + col0) = pack8(acc[ai][0][m][0] * acc[ai][1][m][0] * r2, acc[ai][0][m][1] * acc[ai][1][m][1] * r2); }
        } else {
            bf16_t* base; int colt; float sc = 1.f;
            if (pn < 4) { base = CB; colt = pn * BM; } else if (pn < 16) { base = Q; colt = (pn - 12) * BM; sc = qscale; } else { base = Kb; colt = (pn - 16) * BM; }
            const int col0 = colt + wc * 32 + 8 * fq;
#pragma unroll
            for (int ai = 0; ai < 2; ++ai)
#pragma unroll
                for (int m = 0; m < 4; ++m) { const int row = row0 + ai * HALF + m * 16; const float r = rs_of(sv[ai][m]) * sc;
#pragma unroll
                    for (int bj = 0; bj < 2; ++bj) *(u32x4*)(base + (size_t)row * 1024 + col0 + bj * HALF) = pack8(acc[ai][bj][m][0] * r, acc[ai][bj][m][1] * r); }
        }
    }
};

struct EpiVt {
    static constexpr bool PERM = true, AFTER_DRAIN = false;
    bf16_t* O; const float* ssq;
    __device__ __forceinline__ void operator()(const f32x4 (&acc)[2][2][4][2], const Unit& u, int wr, int wc, int fr, int fq) const {
        const int ch0 = u.pm * BM + wr * 64 + fr, tok0 = u.pn * BM + wc * 32 + 8 * fq;
        f32x4 sc[2][2];
#pragma unroll
        for (int bj = 0; bj < 2; ++bj)
#pragma unroll
            for (int n = 0; n < 2; ++n) {
                if (ssq) { const f32x4 s = *(const f32x4*)(ssq + tok0 + bj * HALF + 4 * n); sc[bj][n] = (f32x4){rs_of(s[0]), rs_of(s[1]), rs_of(s[2]), rs_of(s[3])}; }
                else sc[bj][n] = (f32x4){1.f, 1.f, 1.f, 1.f}; }
#pragma unroll
        for (int ai = 0; ai < 2; ++ai)
#pragma unroll
            for (int m = 0; m < 4; ++m) { const int ch = ch0 + ai * HALF + m * 16;
#pragma unroll
                for (int bj = 0; bj < 2; ++bj) { const int tok = tok0 + bj * HALF;
                    *(u32x4*)(O + ((size_t)(tok >> 11) * 1024 + ch) * 2048 + (tok & 2047)) = pack8(acc[ai][bj][m][0] * sc[bj][0], acc[ai][bj][m][1] * sc[bj][1]); } }
    }
};

template <int SIG> struct EpiGen {
    static constexpr bool PERM = true, AFTER_DRAIN = false;
    bf16_t* O; int ldc; const float* ssq; float sc; const float* bias;
    __device__ __forceinline__ void operator()(const f32x4 (&acc)[2][2][4][2], const Unit& u, int wr, int wc, int fr, int fq) const {
        const int row0 = u.pm * BM + wr * 64 + fr, col0 = u.pn * BM + wc * 32 + 8 * fq;
        f32x4 bv[2][2];
#pragma unroll
        for (int bj = 0; bj < 2; ++bj)
#pragma unroll
            for (int n = 0; n < 2; ++n) bv[bj][n] = bias ? *(const f32x4*)(bias + col0 + bj * HALF + 4 * n) : (f32x4){0.f, 0.f, 0.f, 0.f};
        float sv[2][4];
#pragma unroll
        for (int ai = 0; ai < 2; ++ai)
#pragma unroll
            for (int m = 0; m < 4; ++m) sv[ai][m] = ssq ? ssq[row0 + ai * HALF + m * 16] : 0.f;
#pragma unroll
        for (int ai = 0; ai < 2; ++ai)
#pragma unroll
            for (int m = 0; m < 4; ++m) { const int row = row0 + ai * HALF + m * 16; const float r = (ssq ? rs_of(sv[ai][m]) : 1.f) * sc;
#pragma unroll
                for (int bj = 0; bj < 2; ++bj) { f32x4 v0 = acc[ai][bj][m][0] * r + bv[bj][0], v1 = acc[ai][bj][m][1] * r + bv[bj][1];
                    if (SIG) {
#pragma unroll
                        for (int e = 0; e < 4; ++e) { v0[e] = sigmoid_f(v0[e]); v1[e] = sigmoid_f(v1[e]); } }
                    *(u32x4*)(O + (size_t)row * ldc + col0 + bj * HALF) = pack8(v0, v1); } }
    }
};

template <int ADD> struct EpiGateMul {
    static constexpr bool PERM = true, AFTER_DRAIN = false;
    bf16_t* G; const bf16_t* T;
    __device__ __forceinline__ void operator()(const f32x4 (&acc)[2][2][4][2], const Unit& u, int wr, int wc, int fr, int fq) const {
        const int row0 = u.pm * BM + wr * 64 + fr, col0 = u.pn * BM + wc * 32 + 8 * fq;
#pragma unroll
        for (int ai = 0; ai < 2; ++ai)
#pragma unroll
            for (int m = 0; m < 4; ++m) { const int row = row0 + ai * HALF + m * 16;
#pragma unroll
                for (int bj = 0; bj < 2; ++bj) { const size_t off = (size_t)row * 1024 + col0 + bj * HALF;
                    f32x4 g0, g1; unpack8(*(const u32x4*)(G + off), g0, g1);
                    f32x4 v0 = g0 * acc[ai][bj][m][0], v1 = g1 * acc[ai][bj][m][1];
                    if (ADD) { f32x4 t0, t1; unpack8(*(const u32x4*)(T + off), t0, t1); v0 = v0 + t0; v1 = v1 + t1; }
                    *(u32x4*)(G + off) = pack8(v0, v1); } }
    }
};

struct EpiFinal {
    static constexpr bool PERM = true, AFTER_DRAIN = false;
    const bf16_t* Hin; float* Out; float* ssq; float alpha; const float* gain; unsigned* cnt;
    __device__ __forceinline__ void operator()(const f32x4 (&acc_)[2][2][4][2], const Unit& u, int wr, int wc, int fr, int fq) const {
        f32x4 (&acc)[2][2][4][2] = const_cast<f32x4 (&)[2][2][4][2]>(acc_);
        const int row0 = u.pm * BM + wr * 64 + fr, col0 = u.pn * BM + wc * 32 + 8 * fq;
#pragma unroll
        for (int ai = 0; ai < 2; ++ai)
#pragma unroll
            for (int m = 0; m < 4; ++m) { const int row = row0 + ai * HALF + m * 16; float ss = 0.f;
#pragma unroll
                for (int bj = 0; bj < 2; ++bj) { const size_t off = (size_t)row * 1024 + col0 + bj * HALF;
                    f32x4 a, b; unpack8(*(const u32x4*)(Hin + off), a, b);
                    a = a + acc[ai][bj][m][0] * alpha; b = b + acc[ai][bj][m][1] * alpha;
                    acc[ai][bj][m][0] = a; acc[ai][bj][m][1] = b;
                    ss += (a[0] * a[0] + a[1] * a[1]) + (a[2] * a[2] + a[3] * a[3]) + (b[0] * b[0] + b[1] * b[1]) + (b[2] * b[2] + b[3] * b[3]); }
                ss += __shfl_xor(ss, 16); ss += __shfl_xor(ss, 32);
                if (fq == 0) unsafeAtomicAdd(ssq + row, ss); }
        asm volatile("s_waitcnt vmcnt(0)" ::: "memory");
        unsigned* pc = cnt + u.pm * 32;
        unsigned* pf = pc + 2048;
        if (fr == 0 && fq == 0) { if (__hip_atomic_fetch_add(pc, 1u, __ATOMIC_RELAXED, __HIP_MEMORY_SCOPE_AGENT) == 31u) __hip_atomic_store(pf, 1u, __ATOMIC_RELAXED, __HIP_MEMORY_SCOPE_AGENT); }
        { unsigned sp = 0; while (__hip_atomic_load(pf, __ATOMIC_RELAXED, __HIP_MEMORY_SCOPE_AGENT) == 0u && ++sp < (1u << 22)) __builtin_amdgcn_s_sleep(4); }
        f32x4 gv[2][2];
#pragma unroll
        for (int bj = 0; bj < 2; ++bj)
#pragma unroll
            for (int n = 0; n < 2; ++n) gv[bj][n] = *(const f32x4*)(gain + col0 + bj * HALF + 4 * n);
#pragma unroll
        for (int ai = 0; ai < 2; ++ai)
#pragma unroll
            for (int m = 0; m < 4; ++m) { const int row = row0 + ai * HALF + m * 16;
                const float r = rs_of(__hip_atomic_load(ssq + row, __ATOMIC_RELAXED, __HIP_MEMORY_SCOPE_AGENT));
#pragma unroll
                for (int bj = 0; bj < 2; ++bj) { const size_t off = (size_t)row * 1024 + col0 + bj * HALF;
                    __builtin_nontemporal_store(acc[ai][bj][m][0] * r * gv[bj][0], (f32x4*)(Out + off)); __builtin_nontemporal_store(acc[ai][bj][m][1] * r * gv[bj][1], (f32x4*)(Out + off + 4)); } }
    }
};

struct EpiTileC {
    static constexpr bool PERM = true, AFTER_DRAIN = false;
    bf16_t* O; const float* ssq; float sc; int swap;
    __device__ __forceinline__ void operator()(const f32x4 (&acc)[2][2][4][2], const Unit& u, int wr, int wc, int fr, int fq) const {
        const int tile = swap ? (u.pn * 4 + u.pm) : (u.pm * 4 + u.pn), rl0 = wr * 64 + fr, cl0 = wc * 32 + 8 * fq;
        bf16_t* base = O + (size_t)tile * 65536;
        float sv[2][4];
#pragma unroll
        for (int ai = 0; ai < 2; ++ai)
#pragma unroll
            for (int m = 0; m < 4; ++m) sv[ai][m] = ssq ? ssq[u.pm * BM + rl0 + ai * HALF + m * 16] : 0.f;
#pragma unroll
        for (int ai = 0; ai < 2; ++ai)
#pragma unroll
            for (int m = 0; m < 4; ++m) { const int rl = rl0 + ai * HALF + m * 16; const float r = (ssq ? rs_of(sv[ai][m]) : 1.f) * sc;
#pragma unroll
                for (int bj = 0; bj < 2; ++bj) *(u32x4*)(base + rl * 256 + cl0 + bj * HALF) = pack8(acc[ai][bj][m][0] * r, acc[ai][bj][m][1] * r); }
    }
};
struct EpiSoftmaxP {
    static constexpr bool PERM = true, AFTER_DRAIN = true;
    bf16_t* Pm; float* rsum;
    __device__ __forceinline__ void fused(const f32x4 (&acc)[2][2][4][2], const Unit& u, int wr, int wc, int fr, int fq, PG8_LAS unsigned char* lds, int, int) const {
        PG8_LAS float* red = (PG8_LAS float*)lds;
        const int rl0 = wr * 64 + fr, cl0 = wc * 32 + 8 * fq;
        float mx[2][4];
#pragma unroll
        for (int ai = 0; ai < 2; ++ai)
#pragma unroll
            for (int m = 0; m < 4; ++m) { float v = acc[ai][0][m][0][0];
#pragma unroll
                for (int bj = 0; bj < 2; ++bj)
#pragma unroll
                    for (int n = 0; n < 2; ++n)
#pragma unroll
                        for (int e = 0; e < 4; ++e) v = __builtin_fmaxf(v, acc[ai][bj][m][n][e]);
                v = __builtin_fmaxf(v, __shfl_xor(v, 16)); v = __builtin_fmaxf(v, __shfl_xor(v, 32));
                if (fq == 0) red[(rl0 + ai * HALF + m * 16) * 4 + wc] = v; }
        __syncthreads();
#pragma unroll
        for (int ai = 0; ai < 2; ++ai)
#pragma unroll
            for (int m = 0; m < 4; ++m) { const f32x4 t = *(const PG8_LAS f32x4*)(red + (rl0 + ai * HALF + m * 16) * 4); mx[ai][m] = __builtin_fmaxf(__builtin_fmaxf(t[0], t[1]), __builtin_fmaxf(t[2], t[3])); }
        __syncthreads();
        bf16_t* base = Pm + (size_t)u.pm * 65536;
#pragma unroll
        for (int ai = 0; ai < 2; ++ai)
#pragma unroll
            for (int m = 0; m < 4; ++m) { const int rl = rl0 + ai * HALF + m * 16; float sm = 0.f;
#pragma unroll
                for (int bj = 0; bj < 2; ++bj) { f32x4 p0, p1;
#pragma unroll
                    for (int e = 0; e < 4; ++e) { p0[e] = __builtin_amdgcn_exp2f(acc[ai][bj][m][0][e] - mx[ai][m]); p1[e] = __builtin_amdgcn_exp2f(acc[ai][bj][m][1][e] - mx[ai][m]); }
                    sm += (p0[0] + p0[1]) + (p0[2] + p0[3]) + (p1[0] + p1[1]) + (p1[2] + p1[3]);
                    *(u32x4*)(base + rl * 256 + cl0 + bj * HALF) = pack8(p0, p1); }
                sm += __shfl_xor(sm, 16); sm += __shfl_xor(sm, 32);
                if (fq == 0) red[rl * 4 + wc] = sm; }
        __syncthreads();
        if (wc == 0 && fq == 0) {
#pragma unroll
            for (int ai = 0; ai < 2; ++ai)
#pragma unroll
                for (int m = 0; m < 4; ++m) { const int rl = rl0 + ai * HALF + m * 16; const f32x4 t = *(const PG8_LAS f32x4*)(red + rl * 4); rsum[u.pm * 256 + rl] = (t[0] + t[1]) + (t[2] + t[3]); }
        }
    }
};
struct EpiO {
    static constexpr bool PERM = true, AFTER_DRAIN = false;
    bf16_t* OX; const float* rsum;
    __device__ __forceinline__ void operator()(const f32x4 (&acc)[2][2][4][2], const Unit& u, int wr, int wc, int fr, int fq) const {
        const int rl0 = wr * 64 + fr, cl0 = wc * 32 + 8 * fq, hx = u.pm & 3, row0 = (u.pm >> 2) * BM;
        float sv[2][4];
#pragma unroll
        for (int ai = 0; ai < 2; ++ai)
#pragma unroll
            for (int m = 0; m < 4; ++m) sv[ai][m] = rsum[u.pm * 256 + rl0 + ai * HALF + m * 16];
#pragma unroll
        for (int ai = 0; ai < 2; ++ai)
#pragma unroll
            for (int m = 0; m < 4; ++m) { const int rl = rl0 + ai * HALF + m * 16; const float r = __builtin_amdgcn_rcpf(sv[ai][m]);
#pragma unroll
                for (int bj = 0; bj < 2; ++bj) *(u32x4*)(OX + (size_t)(row0 + rl) * 1024 + hx * 256 + cl0 + bj * HALF) = pack8(acc[ai][bj][m][0] * r, acc[ai][bj][m][1] * r); }
    }
};
struct OrderOne {
    int tA, tB;
    __device__ __forceinline__ bool next(int i, Unit& u) const { if (i > 0) return false; u.pm = tA; u.pn = tB; u.job = 0; return true; }
    __device__ __forceinline__ const char* baseA(const Gemm& g, const Unit&) const { return (const char*)g.A; }
    __device__ __forceinline__ const char* baseB(const Gemm& g, const Unit&) const { return (const char*)g.Bt; }
    __device__ __forceinline__ void a_ready(const Unit&) const {}
    __device__ __forceinline__ void done(const Unit&) const {}
};

template <class Epi, class Sched, bool ALIGN_EPI = false, bool SP2 = false>
__device__ __forceinline__ void gemm_phase(PG8_LAS unsigned char* lds, const Gemm g, const Sched& S, const Epi& E) {
    int tid_o = threadIdx.x; asm volatile("" : "+v"(tid_o));
    const int tid = tid_o, wid = __builtin_amdgcn_readfirstlane(tid >> 6), lane = tid & 63, wr = wid >> 2, wc = wid & 3, fr = lane & 15, fq = lane >> 4;
    const int K = g.K, nt = K / BK;
    unsigned voffA[2], voffB[2];
#pragma unroll
    for (int i = 0; i < 2; ++i) { int R, C; stage_rc(tid * 16 + i * 8192, R, C); const int Rb = Epi::PERM ? ((R & ~31) + perm32(R & 31)) : R;
        voffA[i] = (unsigned)(R * K + C) * 2u; voffB[i] = (unsigned)(Rb * K + C) * 2u; }
    const size_t kstep = (size_t)(BK * 2);
    const size_t hstep = (size_t)HALF * K * 2;
    const size_t tstep = 2 * hstep;
    const unsigned ldsw = (unsigned)wid * 1024u;
    const int aoff = lds_byte(wr * 64 + fr, fq * 8), boff = lds_byte(wc * 32 + fr, fq * 8);
#define PG8_SA(b, h) (((b) * 2 + (h)) * HTB)
#define PG8_SB(b, h) ((4 + (b) * 2 + (h)) * HTB)
#define PG8_STAGE(bufoff, gbase, voff) do { _Pragma("unroll") for (int _i = 0; _i < 2; ++_i) \
        __builtin_amdgcn_global_load_lds((const unsigned*)((const char*)(gbase) + (voff)[_i]), (PG8_LAS unsigned*)(lds + (bufoff) + ldsw + _i * 8192), 16, 0, 0); } while (0)
#define PG8_LDA(dst, b, h) do { _Pragma("unroll") for (int m = 0; m < 4; ++m) _Pragma("unroll") for (int k = 0; k < 2; ++k) dst[m][k] = *(const PG8_LAS bf16x8*)(lds + PG8_SA(b, h) + aoff + m * 2048 + k * 1024); } while (0)
#define PG8_LDB(dst, b, h) do { _Pragma("unroll") for (int n = 0; n < 2; ++n) _Pragma("unroll") for (int k = 0; k < 2; ++k) dst[n][k] = *(const PG8_LAS bf16x8*)(lds + PG8_SB(b, h) + boff + n * 2048 + k * 1024); } while (0)
#define PG8_MMA(ai, bj, At, Bt) do { __builtin_amdgcn_s_setprio(1); _Pragma("unroll") for (int m = 0; m < 4; ++m) _Pragma("unroll") for (int n = 0; n < 2; ++n) _Pragma("unroll") for (int k = 0; k < 2; ++k) \
        acc[ai][bj][m][n] = __builtin_amdgcn_mfma_f32_16x16x32_bf16(Bt[n][k], At[m][k], acc[ai][bj][m][n], 0, 0, 0); __builtin_amdgcn_s_setprio(0); } while (0)
#define PG8_WAIT_V(n) asm volatile("s_waitcnt vmcnt(" #n ")" ::: "memory")
#define PG8_WAIT_L(n) asm volatile("s_waitcnt lgkmcnt(" #n ")" ::: "memory")
#define PG8_BAR __builtin_amdgcn_s_barrier()
#define PG8_SCHED __builtin_amdgcn_sched_barrier(0)
    Unit cur, nxt; int ui = 0;
    if (!S.next(0, cur)) return;
    f32x4 acc[2][2][4][2];
#pragma unroll
    for (int a = 0; a < 2; ++a)
#pragma unroll
        for (int b = 0; b < 2; ++b)
#pragma unroll
            for (int m = 0; m < 4; ++m)
#pragma unroll
                for (int n = 0; n < 2; ++n) acc[a][b][m][n] = (f32x4){0.f, 0.f, 0.f, 0.f};
    bf16x8 At[4][2], B0[2][2], B1[2][2];
    const char* cA = S.baseA(g, cur) + (size_t)cur.pm * tstep; const char* cB = S.baseB(g, cur) + (size_t)cur.pn * tstep;
    S.a_ready(cur);
    if constexpr (SP2) {
        PG8_STAGE(PG8_SB(0, 0), cB, voffB); PG8_STAGE(PG8_SB(0, 1), cB + hstep, voffB); PG8_STAGE(PG8_SA(0, 0), cA, voffA); PG8_STAGE(PG8_SA(0, 1), cA + hstep, voffA);
        if (wr == 1) PG8_BAR;
        PG8_WAIT_V(2); PG8_BAR;
        PG8_STAGE(PG8_SB(1, 0), cB + kstep, voffB); PG8_STAGE(PG8_SA(1, 0), cA + kstep, voffA); PG8_STAGE(PG8_SB(1, 1), cB + hstep + kstep, voffB);
        PG8_WAIT_V(6); PG8_BAR;
    } else {
        PG8_STAGE(PG8_SB(0, 0), cB, voffB); PG8_STAGE(PG8_SA(0, 0), cA, voffA); PG8_STAGE(PG8_SB(0, 1), cB + hstep, voffB); PG8_STAGE(PG8_SA(0, 1), cA + hstep, voffA);
        if (wr == 1) PG8_BAR;
        PG8_WAIT_V(4); PG8_BAR;
        PG8_STAGE(PG8_SB(1, 0), cB + kstep, voffB); PG8_STAGE(PG8_SA(1, 0), cA + kstep, voffA); PG8_STAGE(PG8_SB(1, 1), cB + hstep + kstep, voffB);
        PG8_WAIT_V(6); PG8_BAR;
    }
    for (;;) {
        const bool has_next = S.next(ui + 1, nxt);
        const char* nA = has_next ? S.baseA(g, nxt) + (size_t)nxt.pm * tstep : cA; const char* nB = has_next ? S.baseB(g, nxt) + (size_t)nxt.pn * tstep : cB;
        for (int t = 0; t < nt; t += 2) {
            const bool last = (t == nt - 2);
            const char* a1 = cA + (size_t)(t + 1) * kstep;
            const char* a2 = last ? nA : cA + (size_t)(t + 2) * kstep; const char* b2 = last ? nB : cB + (size_t)(t + 2) * kstep;
            const char* a3 = a2 + kstep; const char* b3 = b2 + kstep;
            if (last && has_next) S.a_ready(nxt);
            if constexpr (SP2) {
            PG8_LDB(B0, 0, 0); PG8_LDB(B1, 0, 1); PG8_SCHED; PG8_LDA(At, 0, 0); PG8_STAGE(PG8_SA(1, 1), a1 + hstep, voffA);
            PG8_WAIT_V(8); PG8_WAIT_L(0); PG8_BAR; PG8_MMA(0, 0, At, B0); PG8_MMA(0, 1, At, B1); PG8_BAR; PG8_SCHED;
            PG8_LDA(At, 0, 1); PG8_STAGE(PG8_SB(0, 0), b2, voffB); PG8_STAGE(PG8_SB(0, 1), b2 + hstep, voffB); PG8_STAGE(PG8_SA(0, 0), a2, voffA);
            PG8_WAIT_V(8); PG8_WAIT_L(0); PG8_BAR; PG8_MMA(1, 0, At, B0); PG8_MMA(1, 1, At, B1); PG8_BAR; PG8_SCHED;
            PG8_LDB(B0, 1, 0); PG8_LDB(B1, 1, 1); PG8_SCHED; PG8_LDA(At, 1, 0); PG8_STAGE(PG8_SA(0, 1), a2 + hstep, voffA);
            PG8_WAIT_V(8); PG8_WAIT_L(0); PG8_BAR; PG8_MMA(0, 0, At, B0); PG8_MMA(0, 1, At, B1); PG8_BAR; PG8_SCHED;
            PG8_LDA(At, 1, 1); PG8_STAGE(PG8_SB(1, 0), b3, voffB); PG8_STAGE(PG8_SB(1, 1), b3 + hstep, voffB); PG8_STAGE(PG8_SA(1, 0), a3, voffA);
            PG8_WAIT_V(8); PG8_WAIT_L(0); PG8_BAR; PG8_MMA(1, 0, At, B0); PG8_MMA(1, 1, At, B1); PG8_BAR; PG8_SCHED;
            } else {
            PG8_LDB(B0, 0, 0); PG8_SCHED; PG8_LDA(At, 0, 0); PG8_STAGE(PG8_SA(1, 1), a1 + hstep, voffA);
            PG8_WAIT_L(8); PG8_BAR; PG8_WAIT_L(0); PG8_MMA(0, 0, At, B0); PG8_BAR; PG8_SCHED;
            PG8_LDB(B1, 0, 1); PG8_STAGE(PG8_SB(0, 0), b2, voffB);
            PG8_BAR; PG8_WAIT_L(0); PG8_MMA(0, 1, At, B1); PG8_BAR;
            PG8_LDA(At, 0, 1); PG8_STAGE(PG8_SA(0, 0), a2, voffA);
            PG8_BAR; PG8_WAIT_L(0); PG8_MMA(1, 0, At, B0); PG8_BAR; PG8_SCHED;
            PG8_STAGE(PG8_SB(0, 1), b2 + hstep, voffB);
            PG8_WAIT_V(6); PG8_BAR; PG8_MMA(1, 1, At, B1); PG8_BAR;
            PG8_LDB(B0, 1, 0); PG8_SCHED; PG8_LDA(At, 1, 0); PG8_STAGE(PG8_SA(0, 1), a2 + hstep, voffA);
            PG8_WAIT_L(8); PG8_BAR; PG8_WAIT_L(0); PG8_MMA(0, 0, At, B0); PG8_BAR; PG8_SCHED;
            PG8_LDB(B1, 1, 1); PG8_STAGE(PG8_SB(1, 0), b3, voffB);
            PG8_BAR; PG8_WAIT_L(0); PG8_MMA(0, 1, At, B1); PG8_BAR;
            PG8_LDA(At, 1, 1); PG8_STAGE(PG8_SA(1, 0), a3, voffA);
            PG8_BAR; PG8_WAIT_L(0); PG8_MMA(1, 0, At, B0); PG8_BAR; PG8_SCHED;
            PG8_STAGE(PG8_SB(1, 1), b3 + hstep, voffB);
            PG8_WAIT_V(6); PG8_BAR; PG8_MMA(1, 1, At, B1); PG8_BAR;
            }
        }
        if constexpr (ALIGN_EPI) { if (wr == 0) PG8_BAR; }
        if constexpr (!Epi::AFTER_DRAIN) { E(acc, cur, wr, wc, fr, fq); S.done(cur); }
        if (!has_next) break;
#pragma unroll
        for (int a = 0; a < 2; ++a)
#pragma unroll
            for (int b = 0; b < 2; ++b)
#pragma unroll
                for (int m = 0; m < 4; ++m)
#pragma unroll
                    for (int n = 0; n < 2; ++n) acc[a][b][m][n] = (f32x4){0.f, 0.f, 0.f, 0.f};
        cur = nxt; cA = nA; cB = nB; ++ui;
        if constexpr (ALIGN_EPI) { if (wr == 1) PG8_BAR; }
    }
    PG8_WAIT_V(0);
    if constexpr (!ALIGN_EPI) { if (wr == 0) PG8_BAR; }
    PG8_BAR;
    if constexpr (Epi::AFTER_DRAIN) { E.fused(acc, cur, wr, wc, fr, fq, lds, wid, lane); S.done(cur); }
#undef PG8_SA
#undef PG8_SB
#undef PG8_STAGE
#undef PG8_LDA
#undef PG8_LDB
#undef PG8_MMA
#undef PG8_WAIT_V
#undef PG8_WAIT_L
#undef PG8_BAR
#undef PG8_SCHED
}
}

constexpr int NWAVES = 8, NTHREADS = NWAVES * 64;
constexpr int BATCH = 8, SEQ = 2048, DM = 1024, M = BATCH * SEQ, DFF = 2816, MEMLEN = 256, MM = BATCH * MEMLEN;
constexpr int NIN = 8192;
constexpr float QSCALE_SB = 0.08838834764831845f * 1.4426950408889634f;
constexpr float QSCALE_X = 0.0625f * 1.4426950408889634f;

constexpr size_t KiB = 1024, MiB = 1u << 20;
constexpr size_t WS_WGU = 0;
constexpr size_t WS_WD = 11 * MiB;
constexpr size_t WS_WIN = WS_WD + 5632 * KiB;
constexpr size_t WS_WCO = WS_WIN + 16 * MiB;
constexpr size_t WS_WAO = WS_WCO + 2 * MiB;
constexpr size_t WS_WO = WS_WAO + 2 * MiB;
constexpr size_t WS_WCQ = WS_WO + 2 * MiB;
constexpr size_t WS_WCKV = WS_WCQ + 2 * MiB;
constexpr size_t WS_WXO = WS_WCKV + 4 * MiB;
constexpr size_t WS_MN = WS_WXO + 2 * MiB;
constexpr size_t WS_KX = WS_MN + 4 * MiB;
constexpr size_t WS_VXT = WS_KX + 4 * MiB;
constexpr size_t WS_SSQ = WS_VXT + 4 * MiB;
constexpr size_t WS_S0 = WS_SSQ + 512 * KiB;
constexpr size_t SLOT = 32 * MiB;
constexpr size_t WS_END = WS_S0 + 6 * SLOT;
static_assert(WS_END + 32768 <= 256 * MiB, "d_ws map");

constexpr int LDS_RING = 139264, LDS_BYTES = LDS_RING + 64;
constexpr size_t WS_BAR = WS_END, BAR_BYTES = 65536;
constexpr size_t WS_RSUM = WS_BAR + BAR_BYTES;
static_assert(WS_RSUM + 262144 <= 256 * MiB, "d_ws map");
constexpr size_t WS_PANEL = WS_BAR + 32768;

#define GAS __attribute__((address_space(1)))
#define LAS __attribute__((address_space(3)))
#define DI __device__ __forceinline__
typedef unsigned short bf16;
typedef unsigned u32x4 __attribute__((ext_vector_type(4)));
typedef unsigned u32x2 __attribute__((ext_vector_type(2)));
typedef float f32x4 __attribute__((ext_vector_type(4)));
typedef float f32x16 __attribute__((ext_vector_type(16)));
typedef short bf16x8 __attribute__((ext_vector_type(8)));
#define LDS_WAIT() asm volatile("s_waitcnt lgkmcnt(0)" ::: "memory")
#define MFMA32(a, b, c) __builtin_amdgcn_mfma_f32_32x32x16_bf16((a), (b), (c), 0, 0, 0)
using pg8::cvt_pk_bf16; using pg8::pack8; using pg8::unpack8; using pg8::rs_of;

DI float wave_sum(float v) {
#pragma unroll
    for (int o = 1; o < 64; o <<= 1) v += __shfl_xor(v, o);
    return v;
}

DI void tr_load(float (&wv)[32], const float* W, int N, int k0, int n0, int lane) {
    const float* wp = W + (size_t)(k0 + (lane >> 5)) * N + n0 + (lane & 31);
#pragma unroll
    for (int i = 0; i < 32; ++i) wv[i] = __builtin_nontemporal_load(wp + (size_t)(2 * i) * N);
}
DI void tr_finish(float (&wv)[32], int K, bf16* WT, int dst_row0, const float* gain, LAS float* scr, int k0, int lane) {
    if (gain) {
#pragma unroll
        for (int i = 0; i < 32; ++i) wv[i] *= gain[k0 + 2 * i + (lane >> 5)];
    }
#pragma unroll
    for (int i = 0; i < 32; ++i) scr[(2 * i + (lane >> 5)) * 33 + (lane & 31)] = wv[i];
    LDS_WAIT(); asm volatile("" ::: "memory");
    const int c = lane & 7;
#pragma unroll
    for (int j = 0; j < 4; ++j) { const int n = (lane >> 3) + 8 * j; const LAS float* s = scr + (8 * c) * 33 + n;
        u32x4 o; o.x = cvt_pk_bf16(s[0 * 33], s[1 * 33]); o.y = cvt_pk_bf16(s[2 * 33], s[3 * 33]); o.z = cvt_pk_bf16(s[4 * 33], s[5 * 33]); o.w = cvt_pk_bf16(s[6 * 33], s[7 * 33]);
        *(u32x4*)(WT + (size_t)(dst_row0 + n) * K + k0 + 8 * c) = o; }
    LDS_WAIT(); asm volatile("" ::: "memory");
}
template <int MAP> DI int map_row(int n0) {
    if (MAP == 1) { const int j = n0 < DFF ? n0 : n0 - DFF; return (j >> 7) * 256 + (n0 < DFF ? 0 : 128) + (j & 127); }
    if (MAP == 2) { if (n0 >= 1024 && n0 < 3072) { const int j = (n0 - 1024) & 1023; return 1024 + (j >> 7) * 256 + (n0 < 2048 ? 0 : 128) + (j & 127); } return n0; }
    return n0;
}
template <int MAP> DI void convert_weight(const float* W, int K, int N, bf16* WT, const float* gain, LAS float* scr, int gw, int ngw, int lane) {
    const int nblk = N / 32, items = (K / 64) * nblk;
    int it = gw; if (it >= items) return;
    float ra[32], rb[32];
    tr_load(ra, W, N, 64 * (it / nblk), 32 * (it % nblk), lane);
    for (;;) {
        int nx = it + ngw; bool hn = nx < items;
        if (hn) tr_load(rb, W, N, 64 * (nx / nblk), 32 * (nx % nblk), lane);
        tr_finish(ra, K, WT, map_row<MAP>(32 * (it % nblk)), gain, scr, 64 * (it / nblk), lane);
        if (!hn) break;
        it = nx; nx = it + ngw; hn = nx < items;
        if (hn) tr_load(ra, W, N, 64 * (nx / nblk), 32 * (nx % nblk), lane);
        tr_finish(rb, K, WT, map_row<MAP>(32 * (it % nblk)), gain, scr, 64 * (it / nblk), lane);
        if (!hn) break;
        it = nx;
    }
}

struct CvtItem { const float* W; bf16* WT; const float* gain; int K, N, map, it; };
template <int LIST> DI bool cvt_decode(int g, const float* const* in, unsigned char* ws, CvtItem& c);
DI void cvt_load(float (&r)[32], const CvtItem& c, int lane) { const int nblk = c.N >> 5; tr_load(r, c.W, c.N, 64 * (c.it / nblk), 32 * (c.it % nblk), lane); }
DI void cvt_finish(float (&r)[32], const CvtItem& c, LAS float* scr, int lane) { const int nblk = c.N >> 5, n0 = 32 * (c.it % nblk);
    const int dst = c.map == 1 ? map_row<1>(n0) : c.map == 2 ? map_row<2>(n0) : n0; tr_finish(r, c.K, c.WT, dst, c.gain, scr, 64 * (c.it / nblk), lane); }
template <int LIST> DI void convert_list(const float* const* in, unsigned char* ws, LAS float* scr, int gw, int ngw, int lane) {
    int g = gw; CvtItem ca, cb; if (!cvt_decode<LIST>(g, in, ws, ca)) return;
    float ra[32], rb[32];
    cvt_load(ra, ca, lane);
    for (;;) {
        bool hn = cvt_decode<LIST>(g + ngw, in, ws, cb);
        if (hn) cvt_load(rb, cb, lane);
        cvt_finish(ra, ca, scr, lane);
        if (!hn) break;
        g += ngw; hn = cvt_decode<LIST>(g + ngw, in, ws, ca);
        if (hn) cvt_load(ra, ca, lane);
        cvt_finish(rb, cb, scr, lane);
        if (!hn) break;
        g += ngw;
    }
}

DI int crow(int i, int h) { return (i & 3) + 8 * (i >> 2) + 4 * h; }
constexpr int SB_KROW = 272, SB_VROW = 72, SB_KB = 32 * SB_KROW, SB_VB = 128 * SB_VROW, SB_BUF = SB_KB + SB_VB;

DI void sb_unit(LAS unsigned char* lds, bf16* Q  , const bf16* Kb, const bf16* Vt, int b, int hh, int qb, int tid, int wave, int lane) {
    const int r = lane & 31, h = lane >> 5, q0 = qb * 256;
    bf16* qp = Q + (size_t)(b * SEQ + q0 + wave * 32 + r) * 1024 + hh * 128;
    bf16x8 qf[8];
#pragma unroll
    for (int s = 0; s < 8; ++s) qf[s] = *(const bf16x8*)(qp + 16 * s + 8 * h);
    f32x16 o[4];
#pragma unroll
    for (int d = 0; d < 4; ++d)
#pragma unroll
        for (int i = 0; i < 16; ++i) o[d][i] = 0.f;
    float carry = 1.f; bool alive = true;
    volatile LAS int* fl = (volatile LAS int*)(lds + 2 * SB_BUF);
    const int nkt = (q0 + 256) / 32, dt = qb * 8 + wave;
    const int kr_ = tid >> 4, kch = tid & 15;
    const bf16* kg = Kb + (size_t)(b * SEQ + kr_) * 1024 + hh * 128 + kch * 8;
    const unsigned kl = kr_ * SB_KROW + kch * 16;
    const int vd = tid >> 2, vch = tid & 3;
    const bf16* vg = Vt + ((size_t)(b * 8 + hh) * 128 + vd) * SEQ + vch * 8;
    const unsigned vl = SB_KB + vd * SB_VROW + vch * 16;
    u32x4 kreg = *(const u32x4*)(kg + (size_t)(nkt - 1) * 32 * 1024), vreg = *(const u32x4*)(vg + (nkt - 1) * 32);
    *(LAS u32x4*)(lds + kl) = kreg; *(LAS u32x2*)(lds + vl) = (u32x2){vreg.x, vreg.y}; *(LAS u32x2*)(lds + vl + 8) = (u32x2){vreg.z, vreg.w};
    __syncthreads();
    for (int kt = nkt - 1; kt >= 0; --kt) {
        const int cur = (nkt - 1 - kt) & 1;
        LAS unsigned char* kb = lds + cur * SB_BUF; LAS unsigned char* vb = kb + SB_KB;
        if (kt > 0) { kreg = *(const u32x4*)(kg + (size_t)(kt - 1) * 32 * 1024); vreg = *(const u32x4*)(vg + (kt - 1) * 32); }
        if (kt <= dt && alive) {
            f32x16 x;
#pragma unroll
            for (int i = 0; i < 16; ++i) x[i] = 0.f;
#pragma unroll
            for (int s = 0; s < 8; ++s) { const bf16x8 a = *(const LAS bf16x8*)(kb + r * SB_KROW + (16 * s + 8 * h) * 2); x = MFMA32(a, qf[s], x); }
            float bt[16], om[16];
#pragma unroll
            for (int i = 0; i < 16; ++i) { const float e = __builtin_amdgcn_exp2f(-x[i]); const float bb = __builtin_amdgcn_rcpf(1.f + e); bt[i] = bb; om[i] = 1.f - bb; }
            if (kt == dt) {
#pragma unroll
                for (int i = 0; i < 16; ++i) { const bool valid = crow(i, h) < r; bt[i] = valid ? bt[i] : 0.f; om[i] = valid ? om[i] : 1.f; }
            }
            float G[4], PG[4];
#pragma unroll
            for (int m = 0; m < 4; ++m) { G[m] = (om[4 * m] * om[4 * m + 1]) * (om[4 * m + 2] * om[4 * m + 3]); PG[m] = __shfl_xor(G[m], 32); }
            const float T0 = G[0] * PG[0], T1 = G[1] * PG[1], T2 = G[2] * PG[2], T3 = G[3] * PG[3];
            float R[4]; R[3] = 1.f; R[2] = T3; R[1] = T3 * T2; R[0] = R[1] * T1;
            const float total = R[0] * T0;
            float p[16];
#pragma unroll
            for (int m = 0; m < 4; ++m) { float a = carry * R[m] * (h == 0 ? PG[m] : 1.f);
                p[4 * m + 3] = bt[4 * m + 3] * a; a *= om[4 * m + 3];
                p[4 * m + 2] = bt[4 * m + 2] * a; a *= om[4 * m + 2];
                p[4 * m + 1] = bt[4 * m + 1] * a; a *= om[4 * m + 1];
                p[4 * m + 0] = bt[4 * m + 0] * a; }
            carry *= total;
            alive = __builtin_amdgcn_ballot_w64(carry != 0.f) != 0ull;
            u32x4 w0, w1;
            w0.x = cvt_pk_bf16(p[0], p[1]); w0.y = cvt_pk_bf16(p[2], p[3]); w0.z = cvt_pk_bf16(p[4], p[5]); w0.w = cvt_pk_bf16(p[6], p[7]);
            w1.x = cvt_pk_bf16(p[8], p[9]); w1.y = cvt_pk_bf16(p[10], p[11]); w1.z = cvt_pk_bf16(p[12], p[13]); w1.w = cvt_pk_bf16(p[14], p[15]);
            const bf16x8 pf0 = __builtin_bit_cast(bf16x8, w0), pf1 = __builtin_bit_cast(bf16x8, w1);
#pragma unroll
            for (int db = 0; db < 4; ++db)
#pragma unroll
                for (int s = 0; s < 2; ++s) { const LAS unsigned char* vp = vb + (32 * db + r) * SB_VROW + (16 * s + 4 * h) * 2;
                    const u32x2 lo = *(const LAS u32x2*)vp, hi = *(const LAS u32x2*)(vp + 16);
                    const u32x4 av = {lo.x, lo.y, hi.x, hi.y};
                    o[db] = MFMA32(__builtin_bit_cast(bf16x8, av), s ? pf1 : pf0, o[db]); }
        }
        if (kt > 0) { LAS unsigned char* nb = lds + (cur ^ 1) * SB_BUF;
            *(LAS u32x4*)(nb + kl) = kreg; *(LAS u32x2*)(nb + vl) = (u32x2){vreg.x, vreg.y}; *(LAS u32x2*)(nb + vl + 8) = (u32x2){vreg.z, vreg.w}; }
        if (lane == 0) fl[cur * 8 + wave] = (kt <= dt && !alive) ? 1 : 0;
        __syncthreads();
        { int nd = 0;
#pragma unroll
          for (int w = 0; w < 8; ++w) nd += fl[cur * 8 + w];
          if (nd == 8) break; }
    }
#pragma unroll
    for (int db = 0; db < 4; ++db)
#pragma unroll
        for (int g = 0; g < 4; ++g) { u32x2 w; w.x = cvt_pk_bf16(o[db][4 * g], o[db][4 * g + 1]); w.y = cvt_pk_bf16(o[db][4 * g + 2], o[db][4 * g + 3]);
            *(u32x2*)(qp + 32 * db + 8 * g + 4 * h) = w; }
}

static_assert(2 * SB_BUF + 64 <= LDS_RING, "attention LDS");

#define XB_TMO      128
#define XB_XCNT(j)  (256  + 64 * (j))
#define XB_XSUB(j)  (1280 + 64 * (j))
#define XB_XGEN(j)  (2304 + 64 * (j))
#define XB_TOP      3328
#define XB_TOPGEN   3392
#define XCD_BAR_WORDS 3456
#define XB_SPIN_CAP (1u << 18)

__device__ __forceinline__ unsigned xb_ld(unsigned* p)              { return __hip_atomic_load(p, __ATOMIC_RELAXED, __HIP_MEMORY_SCOPE_AGENT); }
__device__ __forceinline__ unsigned xb_add(unsigned* p, unsigned v) { return __hip_atomic_fetch_add(p, v, __ATOMIC_RELAXED, __HIP_MEMORY_SCOPE_AGENT); }
__device__ __forceinline__ unsigned xb_xcc_id() { return (unsigned)__builtin_amdgcn_s_getreg((3 << 11) | 20) & 0xFu; }
#define XB_SPIN(cond, bar) do { unsigned _sp = 0; while (cond) { __builtin_amdgcn_s_sleep(4); \
    if ((++_sp & 255u) == 0u) { if (xb_ld(&(bar)[XB_TMO])) break; if (_sp > XB_SPIN_CAP) { atomicAdd(&(bar)[XB_TMO], 1u); break; } } } } while (0)

struct XcdBarrier {
    unsigned* bar; unsigned x;
    volatile LAS unsigned* st;
};

__device__ __forceinline__ XcdBarrier xcd_barrier_post(unsigned* bar, volatile LAS unsigned* st) {
    XcdBarrier b; b.bar = bar; b.x = xb_xcc_id(); b.st = st;
    if (threadIdx.x == 0) (void)xb_add(&bar[XB_XCNT(b.x)], 1u);
    return b;
}
__device__ __forceinline__ void xcd_barrier_complete(unsigned* bar, unsigned x, unsigned& nloc, unsigned& nx) {
    const unsigned G = gridDim.x * gridDim.y * gridDim.z;
    unsigned sum, cnt, mine, sp = 0u;
    for (;;) {
        sum = 0u; cnt = 0u; mine = 0u;
#pragma unroll
        for (unsigned j = 0; j < 16; ++j) { const unsigned c = xb_ld(&bar[XB_XCNT(j)]); sum += c; cnt += (c > 0u) ? 1u : 0u; mine = (j == x) ? c : mine; }
        if (sum == G) break;
        __builtin_amdgcn_s_sleep(1);
        if ((++sp & 255u) == 0u) { if (xb_ld(&bar[XB_TMO])) break; if (sp > XB_SPIN_CAP) { atomicAdd(&bar[XB_TMO], 1u); break; } }
    }
    nloc = mine > 0u ? mine : 1u; nx = cnt > 0u ? cnt : 1u;
}

__device__ __forceinline__ void xcd_barrier(const XcdBarrier& b) {
    asm volatile("s_waitcnt vmcnt(0)" ::: "memory");
    __syncthreads();
    if (threadIdx.x == 0) {
        unsigned* bar = b.bar;
        __builtin_amdgcn_s_waitcnt(0);
        unsigned nloc = b.st[0], nx = b.st[1];
        if (nloc == 0u) { xcd_barrier_complete(bar, b.x, nloc, nx); b.st[0] = nloc; b.st[1] = nx; }
        const unsigned old = xb_add(&bar[XB_XSUB(b.x)], 1u);
        const unsigned gen = old / nloc;
        if (old + 1u == (gen + 1u) * nloc) {
            __builtin_amdgcn_fence(__ATOMIC_RELEASE, "agent");
            asm volatile("s_waitcnt vmcnt(0)" ::: "memory");
            const unsigned og = xb_add(&bar[XB_TOP], 1u);
            const unsigned tg = og / nx;
            if (og + 1u == (tg + 1u) * nx) xb_add(&bar[XB_TOPGEN], 1u);
            else XB_SPIN(xb_ld(&bar[XB_TOPGEN]) == tg, bar);
            __builtin_amdgcn_fence(__ATOMIC_ACQUIRE, "agent");
            xb_add(&bar[XB_XGEN(b.x)], 1u);
            asm volatile("s_waitcnt vmcnt(0)" ::: "memory");
        } else {
            XB_SPIN(xb_ld(&bar[XB_XGEN(b.x)]) == gen, bar);
            __builtin_amdgcn_fence(__ATOMIC_ACQUIRE, "agent");
            asm volatile("s_waitcnt vmcnt(0)" ::: "memory");
        }
    }
    __syncthreads();
}

#define XL_SUB(j) (5120 + 64 * (j))
#define XL_GEN(j) (6144 + 64 * (j))
#define XL_BAD 7168
__device__ __forceinline__ void xcd_local_barrier(const XcdBarrier& b) {
    asm volatile("s_waitcnt vmcnt(0)" ::: "memory");
    __syncthreads();
    if (threadIdx.x == 0) {
        unsigned* bar = b.bar;
        __builtin_amdgcn_s_waitcnt(0);
        const unsigned nloc = b.st[0];
        const unsigned old = xb_add(&bar[XL_SUB(b.x)], 1u);
        const unsigned gen = old / nloc;
        if (old + 1u == (gen + 1u) * nloc) xb_add(&bar[XL_GEN(b.x)], 1u);
        else XB_SPIN(xb_ld(&bar[XL_GEN(b.x)]) == gen, bar);
        __builtin_amdgcn_fence(__ATOMIC_ACQUIRE, "agent");
        asm volatile("s_waitcnt vmcnt(0)" ::: "memory");
    }
    __syncthreads();
}

struct Order1 { pg8::StaticOrder Sa, Sk, Sv; unsigned char* ws; int na;
    DI void init(unsigned char* ws_, int G, int c) { ws = ws_; Sa.init(M, 2 * DFF, G, c); Sk.init(MM, DM, G, (c + 128) % G); Sv.init(DM, MM, G, (c + 96) % G); const int nu = (M / 256) * (2 * DFF / 256); na = c < nu ? (nu - c + G - 1) / G : 0; }
    DI bool next(int i, pg8::Unit& u) const { if (Sa.next(i, u)) return true; if (i == na) { if (Sk.next(0, u)) { u.job = 1; return true; } if (Sv.next(0, u)) { u.job = 2; return true; } } return false; }
    DI const char* baseA(const pg8::Gemm&, const pg8::Unit& u) const { return (const char*)ws + (u.job == 0 ? WS_S0 : u.job == 1 ? WS_MN : WS_WCKV + (size_t)DM * DM * 2); }
    DI const char* baseB(const pg8::Gemm&, const pg8::Unit& u) const { return (const char*)ws + (u.job == 0 ? WS_WGU : u.job == 1 ? WS_WCKV : WS_MN); }
    DI void a_ready(const pg8::Unit&) const {} DI void done(const pg8::Unit&) const {}
};
struct Epi1 { static constexpr bool PERM = true, AFTER_DRAIN = false; unsigned char* ws;
    DI void operator()(const pg8::f32x4 (&acc)[2][2][4][2], const pg8::Unit& u, int wr, int wc, int fr, int fq) const {
        if (u.job == 0) { pg8::EpiSwiGLU e{(pg8::bf16_t*)(ws + WS_S0 + SLOT), (const float*)(ws + WS_SSQ), DFF}; e(acc, u, wr, wc, fr, fq); }
        else if (u.job == 1) { pg8::EpiTileC e{(pg8::bf16_t*)(ws + WS_KX), nullptr, 1.f, 0}; e(acc, u, wr, wc, fr, fq); }
        else { pg8::EpiTileC e{(pg8::bf16_t*)(ws + WS_VXT), nullptr, 1.f, 1}; e(acc, u, wr, wc, fr, fq); }
    }
};
struct Order3 { pg8::StaticOrder Sa, Sv; unsigned char* ws;
    DI void init(unsigned char* ws_, int G, int c) { ws = ws_; Sa.init(M, 5120, G, c); Sv.init(DM, M, G, c); }
    DI bool next(int i, pg8::Unit& u) const { if (Sa.next(i, u)) return true; const int na = (1280 - Sa.c + Sa.G - 1) / Sa.G; if (Sv.next(i - na, u)) { u.job = 1; return true; } return false; }
    DI const char* baseA(const pg8::Gemm&, const pg8::Unit& u) const { return (const char*)ws + (u.job == 0 ? WS_S0 : WS_WIN + (size_t)5120 * DM * 2); }
    DI const char* baseB(const pg8::Gemm&, const pg8::Unit& u) const { return (const char*)ws + (u.job == 0 ? WS_WIN : WS_S0); }
    DI void a_ready(const pg8::Unit&) const {} DI void done(const pg8::Unit&) const {}
};
struct Epi3 { static constexpr bool PERM = true, AFTER_DRAIN = false; unsigned char* ws;
    DI void operator()(const pg8::f32x4 (&acc)[2][2][4][2], const pg8::Unit& u, int wr, int wc, int fr, int fq) const {
        const float* ssq1 = (const float*)(ws + WS_SSQ) + M;
        if (u.job == 0) { pg8::EpiMixIn e{(pg8::bf16_t*)(ws + WS_S0 + SLOT), (pg8::bf16_t*)(ws + WS_S0 + 2 * SLOT), (pg8::bf16_t*)(ws + WS_S0 + 3 * SLOT), (pg8::bf16_t*)(ws + WS_S0 + 4 * SLOT), ssq1, QSCALE_SB}; e(acc, u, wr, wc, fr, fq); }
        else { pg8::EpiVt e{(pg8::bf16_t*)(ws + WS_S0 + 5 * SLOT), ssq1}; e(acc, u, wr, wc, fr, fq); }
    }
};
struct Order5 { pg8::StaticOrder S; unsigned char* ws;
    DI void init(unsigned char* ws_, int G, int c) { ws = ws_; S.init(M, DM, G, c); }
    DI bool next(int i, pg8::Unit& u) const { if (i >= 4) return false; if (!S.next(0, u)) return false; u.job = i; return true; }
    DI const char* baseA(const pg8::Gemm&, const pg8::Unit& u) const { return (const char*)ws + (u.job == 1 ? WS_S0 + SLOT : u.job == 3 ? WS_S0 + 3 * SLOT : WS_S0); }
    DI const char* baseB(const pg8::Gemm&, const pg8::Unit& u) const { return (const char*)ws + (u.job == 0 ? WS_WIN + (size_t)6144 * DM * 2 : u.job == 1 ? WS_WCO : u.job == 2 ? WS_WIN + (size_t)7168 * DM * 2 : WS_WAO); }
    DI void a_ready(const pg8::Unit&) const {} DI void done(const pg8::Unit&) const {}
};
struct Epi5 { static constexpr bool PERM = true, AFTER_DRAIN = false; unsigned char* ws; const float* bgate;
    DI void operator()(const pg8::f32x4 (&acc)[2][2][4][2], const pg8::Unit& u, int wr, int wc, int fr, int fq) const {
        const float* ssq1 = (const float*)(ws + WS_SSQ) + M; pg8::bf16_t* S4 = (pg8::bf16_t*)(ws + WS_S0 + 4 * SLOT); pg8::bf16_t* S5 = (pg8::bf16_t*)(ws + WS_S0 + 5 * SLOT);
        if (u.job == 0) { pg8::EpiGen<1> e{S4, DM, ssq1, 1.f, bgate}; e(acc, u, wr, wc, fr, fq); }
        else if (u.job == 1) { pg8::EpiGateMul<0> e{S4, nullptr}; e(acc, u, wr, wc, fr, fq); }
        else if (u.job == 2) { pg8::EpiGen<1> e{S5, DM, ssq1, 1.f, bgate + DM}; e(acc, u, wr, wc, fr, fq); }
        else { pg8::EpiGateMul<1> e{S5, S4}; e(acc, u, wr, wc, fr, fq); }
    }
};
#define GEMM_MULTI(OrderT, EpiT, Kv, ...) do { pg8::Gemm g_{nullptr, nullptr, 0, 0, (Kv)}; OrderT S_; S_.init(ws, G, c); EpiT E_{__VA_ARGS__}; pg8::gemm_phase<EpiT, OrderT, true, true>(lds, g_, S_, E_); } while (0)

struct Params { const float* in[21]; float* out; unsigned char* ws; };
enum { I_X = 0, I_MEM, I_G_FFN1, I_W_FFN1_GU, I_W_FFN1_DOWN, I_G_MIX, I_W_IN, I_B_GATE, I_CONV_W, I_W_CONV_OUT, I_W_ATTN_OUT, I_W_O, I_G_CROSS, I_G_MEM, I_W_CQ, I_W_CKV, I_W_CO,
       I_G_FFN2, I_W_FFN2_GU, I_W_FFN2_DOWN, I_G_FINAL };

template <> DI bool cvt_decode<0>(int g, const float* const* in, unsigned char* ws, CvtItem& c) {
    if (g >= 7808) return false;
    if (g < 2816) { c.W = in[I_W_FFN1_GU]; c.WT = (bf16*)(ws + WS_WGU); c.gain = in[I_G_FFN1]; c.K = DM; c.N = 2 * DFF; c.map = 1; c.it = g; }
    else if (g < 3840) { c.W = in[I_W_CKV]; c.WT = (bf16*)(ws + WS_WCKV); c.gain = nullptr; c.K = DM; c.N = 2 * DM; c.map = 0; c.it = g - 2816; }
    else if (g < 5248) { c.W = in[I_W_FFN1_DOWN]; c.WT = (bf16*)(ws + WS_WD); c.gain = nullptr; c.K = DFF; c.N = DM; c.map = 0; c.it = g - 3840; }
    else { const int j = (g - 5248) >> 9; c.it = (g - 5248) & 511; c.K = DM; c.N = DM; c.map = 0;
        c.W = in[j == 0 ? I_W_CONV_OUT : j == 1 ? I_W_ATTN_OUT : j == 2 ? I_W_O : j == 3 ? I_W_CQ : I_W_CO];
        c.WT = (bf16*)(ws + (j == 0 ? WS_WCO : j == 1 ? WS_WAO : j == 2 ? WS_WO : j == 3 ? WS_WCQ : WS_WXO));
        c.gain = j == 3 ? in[I_G_CROSS] : nullptr; }
    return true;
}
template <> DI bool cvt_decode<1>(int g, const float* const* in, unsigned char* ws, CvtItem& c) {
    if (g >= 4224) return false;
    if (g < 2816) { c.W = in[I_W_FFN2_GU]; c.WT = (bf16*)(ws + WS_WGU); c.gain = in[I_G_FFN2]; c.K = DM; c.N = 2 * DFF; c.map = 1; c.it = g; }
    else { c.W = in[I_W_FFN2_DOWN]; c.WT = (bf16*)(ws + WS_WD); c.gain = nullptr; c.K = DFF; c.N = DM; c.map = 0; c.it = g - 2816; }
    return true;
}

#define GEMM(EpiT, Aptr, Bptr, Mv, Nv, Kv, cid, ...) do { pg8::Gemm g_{(const pg8::bf16_t*)(Aptr), (const pg8::bf16_t*)(Bptr), (Mv), (Nv), (Kv)}; pg8::StaticOrder S_; S_.init((Mv), (Nv), G, (cid)); \
        EpiT E_{__VA_ARGS__}; pg8::gemm_phase<EpiT, pg8::StaticOrder, true, true>(lds, g_, S_, E_); } while (0)

__global__ void __launch_bounds__(NTHREADS, 2) fwd_megakernel(Params P) {
    extern __shared__ __attribute__((aligned(16))) unsigned char lds_raw[];
    LAS unsigned char* lds = (LAS unsigned char*)lds_raw;
    cg::grid_group grid = cg::this_grid();
    const int tid = threadIdx.x, lane = tid & 63, wave = __builtin_amdgcn_readfirstlane(tid >> 6);
    const int G = gridDim.x, c = blockIdx.x;
    const int gw = c * NWAVES + wave, ngw = G * NWAVES;
    unsigned char* ws = P.ws;
    bf16* WGU = (bf16*)(ws + WS_WGU); bf16* WD = (bf16*)(ws + WS_WD); bf16* WIN = (bf16*)(ws + WS_WIN);
    bf16* WCO = (bf16*)(ws + WS_WCO); bf16* WAO = (bf16*)(ws + WS_WAO); bf16* WO = (bf16*)(ws + WS_WO); bf16* WCQ = (bf16*)(ws + WS_WCQ);
    bf16* WCKV = (bf16*)(ws + WS_WCKV); bf16* WXO = (bf16*)(ws + WS_WXO);
    bf16* MN = (bf16*)(ws + WS_MN); bf16* KX = (bf16*)(ws + WS_KX); bf16* VXT = (bf16*)(ws + WS_VXT);
    float* SSQ = (float*)(ws + WS_SSQ);
    float *ssq0 = SSQ, *ssq1 = SSQ + M, *ssq2 = SSQ + 2 * M, *ssq3 = SSQ + 3 * M, *ssq4 = SSQ + 4 * M;
    bf16* S0 = (bf16*)(ws + WS_S0); bf16* S1 = (bf16*)(ws + WS_S0 + SLOT); bf16* S2 = (bf16*)(ws + WS_S0 + 2 * SLOT); bf16* S3 = (bf16*)(ws + WS_S0 + 3 * SLOT);
    bf16* S4 = (bf16*)(ws + WS_S0 + 4 * SLOT); bf16* S5 = (bf16*)(ws + WS_S0 + 5 * SLOT);
    LAS float* scr = (LAS float*)(lds + wave * 16384);
    volatile LAS unsigned* bst = (volatile LAS unsigned*)(lds + LDS_RING);
    if (tid < 16) bst[tid] = 0u;
    __syncthreads();
    const XcdBarrier xbar = xcd_barrier_post((unsigned*)(ws + WS_BAR), bst);
    if (tid == 0) (void)__hip_atomic_fetch_or((unsigned*)(ws + WS_BAR) + XL_BAD + (c & 7), (1u << xb_xcc_id()) | (G != 256 ? 0x80000000u : 0u), __ATOMIC_RELAXED, __HIP_MEMORY_SCOPE_AGENT);

    {
        convert_list<0>(P.in, ws, scr, gw, ngw, lane);
        for (int m0 = 4 * gw; m0 < M; m0 += 4 * ngw) {
            f32x4 v[4][4];
#pragma unroll
            for (int q = 0; q < 4; ++q)
#pragma unroll
                for (int j = 0; j < 4; ++j) v[q][j] = __builtin_nontemporal_load((const f32x4*)(P.in[I_X] + (size_t)(m0 + q) * DM) + lane + 64 * j);
#pragma unroll
            for (int q = 0; q < 4; ++q) { unsigned long long* o8 = (unsigned long long*)(S0 + (size_t)(m0 + q) * DM) + lane; float s = 0.f;
#pragma unroll
                for (int j = 0; j < 4; ++j) { const f32x4 t = v[q][j]; s += (t.x * t.x + t.y * t.y) + (t.z * t.z + t.w * t.w);
                    o8[64 * j] = (unsigned long long)cvt_pk_bf16(t.x, t.y) | ((unsigned long long)cvt_pk_bf16(t.z, t.w) << 32); }
                s = wave_sum(s); if (lane == 0) ssq0[m0 + q] = s; }
        }
        for (int m = gw; m < MM; m += ngw) {
            const f32x4* xr = (const f32x4*)(P.in[I_MEM] + (size_t)m * DM) + lane; const f32x4* gr = (const f32x4*)P.in[I_G_MEM] + lane;
            unsigned long long* o8 = (unsigned long long*)(MN + (size_t)m * DM) + lane; f32x4 v[4]; float s = 0.f;
#pragma unroll
            for (int j = 0; j < 4; ++j) { v[j] = xr[64 * j]; s += (v[j].x * v[j].x + v[j].y * v[j].y) + (v[j].z * v[j].z + v[j].w * v[j].w); }
            const float rs = rs_of(wave_sum(s));
#pragma unroll
            for (int j = 0; j < 4; ++j) { const f32x4 g = gr[64 * j]; const f32x4 y = v[j] * rs * g;
                o8[64 * j] = (unsigned long long)cvt_pk_bf16(y.x, y.y) | ((unsigned long long)cvt_pk_bf16(y.z, y.w) << 32); }
        }
        for (int i = c * NTHREADS + tid; i < 4 * M; i += G * NTHREADS) ssq1[i] = 0.f;
    }
    if (P.ws == nullptr) grid.sync();
    xcd_barrier(xbar);
    bool fastb;
    {
        if (tid == 0) { unsigned un = 0u; bool one = true;
#pragma unroll
            for (int j = 0; j < 8; ++j) { const unsigned m = xb_ld((unsigned*)(ws + WS_BAR) + XL_BAD + j); one = one && (__builtin_popcount(m) == 1); un |= m; }
            bst[4] = (one && __builtin_popcount(un) == 8 && (un >> 16) == 0u) ? 1u : 0u; }
        __syncthreads();
        fastb = __builtin_amdgcn_readfirstlane((int)bst[4]) != 0; }
#define SEAM_LOCAL() do { if (fastb) xcd_local_barrier(xbar); else xcd_barrier(xbar); } while (0)

    GEMM_MULTI(Order1, Epi1, DM, ws);
    if (G != 256 || c >= 192) {
        const int gw2 = G == 256 ? (c - 192) * NWAVES + wave : gw, ngw2 = G == 256 ? 64 * NWAVES : ngw;
        convert_weight<2>(P.in[I_W_IN], DM, NIN, WIN, P.in[I_G_MIX], scr, gw2, ngw2, lane);
    }
    SEAM_LOCAL();

    GEMM(pg8::EpiResid, S1, WD, M, DM, DFF, c, (pg8::bf16_t*)S0, ssq1, 0.5f);
    xcd_barrier(xbar);

    GEMM_MULTI(Order3, Epi3, DM, ws);
    SEAM_LOCAL();

    {
        convert_list<1>(P.in, ws, scr, gw, ngw, lane);
        const float* cw = P.in[I_CONV_W];
        const int nbb = (G & 7) == 0 ? G >> 3 : 0;
        for (int idx = (nbb ? (c >> 3) : c) * NTHREADS + tid; idx < (nbb ? SEQ * 64 : M * 64); idx += (nbb ? nbb : G) * NTHREADS) {
            const int t = (idx >> 7) * 2 + (nbb ? (c & 7) * SEQ : 0), c8 = (idx & 127) * 8, s = t & (SEQ - 1); const size_t off = (size_t)t * 1024 + c8;
            const u32x4 z4 = {0u, 0u, 0u, 0u};
            const u32x4 r1 = *(const u32x4*)(S2 + off + 1024), r0 = *(const u32x4*)(S2 + off), rm1 = s >= 1 ? *(const u32x4*)(S2 + off - 1024) : z4, rm2 = s >= 2 ? *(const u32x4*)(S2 + off - 2048) : z4;
            const u32x4 cbr0 = *(const u32x4*)(S1 + off), cbr1 = *(const u32x4*)(S1 + off + 1024);
            f32x4 a0, a1, b0, b1, e0, e1, g0, g1, cb0, cb1, cc0, cc1;
            unpack8(r1, g0, g1); unpack8(r0, a0, a1); unpack8(rm1, b0, b1); unpack8(rm2, e0, e1); unpack8(cbr0, cb0, cb1); unpack8(cbr1, cc0, cc1);
            const f32x4 w00 = *(const f32x4*)(cw + c8), w01 = *(const f32x4*)(cw + c8 + 4), w10 = *(const f32x4*)(cw + 1024 + c8), w11 = *(const f32x4*)(cw + 1024 + c8 + 4),
                        w20 = *(const f32x4*)(cw + 2048 + c8), w21 = *(const f32x4*)(cw + 2048 + c8 + 4);
            *(u32x4*)(S1 + off) = pack8(cb0 * (w00 * e0 + w10 * b0 + w20 * a0), cb1 * (w01 * e1 + w11 * b1 + w21 * a1));
            *(u32x4*)(S1 + off + 1024) = pack8(cc0 * (w00 * b0 + w10 * a0 + w20 * g0), cc1 * (w01 * b1 + w11 * a1 + w21 * g1));
        }
        __syncthreads();
        if (nbb) { for (int j = c >> 3; j < 32; j += nbb) { const int b = c & 7, hh = j >> 2, pr = j & 3;
            sb_unit(lds, S3, S4, S5, b, hh, 7 - pr, tid, wave, lane);
            sb_unit(lds, S3, S4, S5, b, hh, pr, tid, wave, lane); } }
        else for (int u = c; u < 256; u += G) { const int bh = u >> 2, pr = u & 3;
            sb_unit(lds, S3, S4, S5, bh >> 3, bh & 7, 7 - pr, tid, wave, lane);
            sb_unit(lds, S3, S4, S5, bh >> 3, bh & 7, pr, tid, wave, lane); }
    }
    xcd_barrier(xbar);

    GEMM_MULTI(Order5, Epi5, DM, ws, P.in[I_B_GATE]);
    SEAM_LOCAL();

    GEMM(pg8::EpiResid, S5, WO, M, DM, DM, c, (pg8::bf16_t*)S0, ssq2, 1.f);
    SEAM_LOCAL();

    GEMM(pg8::EpiTileC, S0, WCQ, M, DM, DM, c, (pg8::bf16_t*)S1, ssq2, QSCALE_X, 0);
    {
#define SYNC_OWN() do { asm volatile("s_waitcnt vmcnt(0)" ::: "memory"); __syncthreads(); if (tid == 0) { __builtin_amdgcn_fence(__ATOMIC_ACQUIRE, "agent"); asm volatile("s_waitcnt vmcnt(0)" ::: "memory"); } __syncthreads(); } while (0)
        float* RS = (float*)(ws + WS_RSUM);
        pg8::StaticOrder So; So.init(M, DM, G, c);
        for (int i = 0;; ++i) { pg8::Unit u0; if (!So.next(i, u0)) break;
            const int tA = u0.pm * 4 + u0.pn, tB = (u0.pm >> 3) * 4 + u0.pn;
            SYNC_OWN();
            { pg8::Gemm g_{(const pg8::bf16_t*)S1, (const pg8::bf16_t*)KX, 0, 0, 256}; pg8::OrderOne S_{tA, tB}; pg8::EpiSoftmaxP E_{(pg8::bf16_t*)S3, RS};
              pg8::gemm_phase<pg8::EpiSoftmaxP, pg8::OrderOne, false, true>(lds, g_, S_, E_); }
            SYNC_OWN();
            { pg8::Gemm g_{(const pg8::bf16_t*)S3, (const pg8::bf16_t*)VXT, 0, 0, 256}; pg8::OrderOne S_{tA, tB}; pg8::EpiO E_{(pg8::bf16_t*)S2, RS};
              pg8::gemm_phase<pg8::EpiO, pg8::OrderOne, true, true>(lds, g_, S_, E_); }
        }
    }
    SEAM_LOCAL();

    GEMM(pg8::EpiResid, S2, WXO, M, DM, DM, c, (pg8::bf16_t*)S0, ssq3, 1.f);
    SEAM_LOCAL();

    GEMM(pg8::EpiSwiGLU, S0, WGU, M, 2 * DFF, DM, c, (pg8::bf16_t*)S1, ssq3, DFF);
    SEAM_LOCAL();

    GEMM(pg8::EpiFinal, S1, WD, M, DM, DFF, c, (const pg8::bf16_t*)S0, P.out, ssq4, 0.5f, P.in[I_G_FINAL], (unsigned*)(ws + WS_PANEL));
}

extern "C" void kernel_launch(void* const* d_in, const int* in_sizes, int n_in, void* d_out, int out_size, void* d_ws, size_t ws_size, hipStream_t stream) {
    static int grid_blocks = 0;
    if (grid_blocks == 0) {
        if (n_in != 21 || out_size != M * DM || ws_size < WS_END) { fprintf(stderr, "kernel_launch: unexpected problem (n_in %d, out %d, ws %zu)\n", n_in, out_size, ws_size); grid_blocks = -1; return; }
        int dev = 0, cus = 0, per_cu = 0;
        (void)hipGetDevice(&dev);
        (void)hipDeviceGetAttribute(&cus, hipDeviceAttributeMultiprocessorCount, dev);
        if (hipFuncSetAttribute((const void*)fwd_megakernel, hipFuncAttributeMaxDynamicSharedMemorySize, LDS_BYTES) != hipSuccess) { fprintf(stderr, "kernel_launch: hipFuncSetAttribute failed\n"); grid_blocks = -1; return; }
        if (hipOccupancyMaxActiveBlocksPerMultiprocessor(&per_cu, (const void*)fwd_megakernel, NTHREADS, LDS_BYTES) != hipSuccess || per_cu < 1) { fprintf(stderr, "kernel_launch: occupancy query failed (%d)\n", per_cu); (void)hipGetLastError(); grid_blocks = -1; return; }
        grid_blocks = cus * per_cu;
    }
    if (grid_blocks < 0) return;
    if (hipMemsetAsync((unsigned char*)d_ws + WS_BAR, 0, BAR_BYTES, stream) != hipSuccess) { fprintf(stderr, "kernel_launch: memset failed\n"); return; }
    Params p{};
    for (int i = 0; i < 21; ++i) p.in[i] = (const float*)d_in[i];
    p.out = (float*)d_out; p.ws = (unsigned char*)d_ws;
    void* args[] = {&p};
    hipError_t e = hipLaunchCooperativeKernel((const void*)fwd_megakernel, dim3(grid_blocks), dim3(NTHREADS), args, LDS_BYTES, stream);
    if (e != hipSuccess) fprintf(stderr, "cooperative launch failed: %s (grid %d)\n", hipGetErrorString(e), grid_blocks);
}
```

```cpp
#include <hip/hip_runtime.h>
#include <hip/hip_cooperative_groups.h>
#include <cstdio>
#include <cstdint>
namespace cg = cooperative_groups;
namespace pg8 {
#define PG8_LAS __attribute__((address_space(3)))
typedef unsigned short bf16_t;
typedef short bf16x8 __attribute__((ext_vector_type(8)));
typedef float f32x4 __attribute__((ext_vector_type(4)));
typedef unsigned u32x4 __attribute__((ext_vector_type(4)));
constexpr int BM = 256, BK = 64, HALF = 128, HTB = HALF * BK * 2  , STAGE_BYTES = 8 * HTB, NXCD = 8, WGM = 8;

__host__ __device__ __forceinline__ int lds_byte(int r, int c) { const int st = (r >> 4) * 2 + (c >> 5), rr = r & 15, cc = c & 31, ob = rr * 64 + cc * 2; return st * 1024 + (ob ^ (((ob >> 9) & 1) << 5)); }
__host__ __device__ __forceinline__ void stage_rc(int b, int& R, int& C) { const int st = b / 1024, sb = b % 1024, swz = sb ^ (((sb >> 9) & 1) << 5); R = (st >> 1) * 16 + swz / 64; C = (st & 1) * 32 + (swz % 64) / 2; }
__host__ __device__ __forceinline__ int perm32(int rho) { const int n = rho >> 4, i = rho & 15; return 8 * (i >> 2) + 4 * n + (i & 3); }

struct Unit { int pm, pn, job; };
struct Gemm { const bf16_t* A; const bf16_t* Bt; int M, N, K; };

struct StaticOrder {
    int nM, nN, nwg, G, c;
    __host__ __device__ void init(int M, int N, int G_, int c_) { nM = M / BM; nN = N / BM; nwg = nM * nN; G = G_; c = c_; }
    __host__ __device__ bool next(int i, Unit& u) const {
        const long L = (long)i * G + c; if (L >= nwg) return false;
        int wgid = (int)L; { const int q = nwg / NXCD, r = nwg % NXCD, xcd = wgid % NXCD, off = wgid / NXCD; wgid = (xcd < r ? xcd * (q + 1) : r * (q + 1) + (xcd - r) * q) + off; }
        const int nig = WGM * nN, gid = wgid / nig, fm = gid * WGM, gsz = (nM - fm) < WGM ? (nM - fm) : WGM;
        u.pm = fm + ((wgid % nig) % gsz); u.pn = (wgid % nig) / gsz; u.job = 0; return true;
    }
    __device__ __forceinline__ const char* baseA(const Gemm& g, const Unit&) const { return (const char*)g.A; }
    __device__ __forceinline__ const char* baseB(const Gemm& g, const Unit&) const { return (const char*)g.Bt; }
    __device__ __forceinline__ void a_ready(const Unit&) const {}
    __device__ __forceinline__ void done(const Unit&) const {}
};

typedef __bf16 bf16x2_t __attribute__((ext_vector_type(2)));
typedef float f32x2_t __attribute__((ext_vector_type(2)));
__device__ __forceinline__ unsigned cvt_pk_bf16(float lo, float hi) { f32x2_t v = {lo, hi}; bf16x2_t b = __builtin_convertvector(v, bf16x2_t); return __builtin_bit_cast(unsigned, b); }
__device__ __forceinline__ u32x4 pack8(f32x4 a, f32x4 b) { u32x4 w; w.x = cvt_pk_bf16(a[0], a[1]); w.y = cvt_pk_bf16(a[2], a[3]); w.z = cvt_pk_bf16(b[0], b[1]); w.w = cvt_pk_bf16(b[2], b[3]); return w; }
__device__ __forceinline__ float bf_lo(unsigned w) { return __builtin_bit_cast(float, w << 16); }
__device__ __forceinline__ float bf_hi(unsigned w) { return __builtin_bit_cast(float, w & 0xffff0000u); }
__device__ __forceinline__ void unpack8(u32x4 w, f32x4& a, f32x4& b) { a = (f32x4){bf_lo(w.x), bf_hi(w.x), bf_lo(w.y), bf_hi(w.y)}; b = (f32x4){bf_lo(w.z), bf_hi(w.z), bf_lo(w.w), bf_hi(w.w)}; }
constexpr float RMS_EPS_F = 1e-6f;
__device__ __forceinline__ float rs_of(float ssq) { return __builtin_amdgcn_rsqf(ssq * (1.f / 1024.f) + RMS_EPS_F); }
__device__ __forceinline__ float sigmoid_f(float v) { return __builtin_amdgcn_rcpf(1.f + __builtin_amdgcn_exp2f(-1.4426950408889634f * v)); }

struct EpiSwiGLU {
    static constexpr bool PERM = true, AFTER_DRAIN = false;
    bf16_t* O; const float* ssq; int ldo;
    __device__ __forceinline__ void operator()(const f32x4 (&acc)[2][2][4][2], const Unit& u, int wr, int wc, int fr, int fq) const {
        const int row0 = u.pm * BM + wr * 64 + fr, col0 = u.pn * HALF + wc * 32 + 8 * fq;
        float sv[2][4];
#pragma unroll
        for (int ai = 0; ai < 2; ++ai)
#pragma unroll
            for (int m = 0; m < 4; ++m) sv[ai][m] = ssq[row0 + ai * HALF + m * 16];
#pragma unroll
        for (int ai = 0; ai < 2; ++ai)
#pragma unroll
            for (int m = 0; m < 4; ++m) { const int row = row0 + ai * HALF + m * 16; const float r = rs_of(sv[ai][m]), k1 = -1.4426950408889634f * r, r2 = r * r;
                f32x4 o[2];
#pragma unroll
                for (int n = 0; n < 2; ++n) { const f32x4 ag = acc[ai][0][m][n], gu = ag * acc[ai][1][m][n];
#pragma unroll
                    for (int e = 0; e < 4; ++e) o[n][e] = gu[e] * (r2 * __builtin_amdgcn_rcpf(1.f + __builtin_amdgcn_exp2f(ag[e] * k1))); }
                *(u32x4*)(O + (size_t)row * ldo + col0) = pack8(o[0], o[1]); }
    }
};

struct EpiResid {
    static constexpr bool PERM = true, AFTER_DRAIN = false;
    bf16_t* HB; float* ssq; float alpha;
    __device__ __forceinline__ void operator()(const f32x4 (&acc)[2][2][4][2], const Unit& u, int wr, int wc, int fr, int fq) const {
        const int row0 = u.pm * BM + wr * 64 + fr, col0 = u.pn * BM + wc * 32 + 8 * fq;
#pragma unroll
        for (int ai = 0; ai < 2; ++ai)
#pragma unroll
            for (int m = 0; m < 4; ++m) { const int row = row0 + ai * HALF + m * 16; float ss = 0.f;
#pragma unroll
                for (int bj = 0; bj < 2; ++bj) { const size_t off = (size_t)row * 1024 + col0 + bj * HALF;
                    f32x4 a, b; unpack8(*(const u32x4*)(HB + off), a, b);
                    a = a + acc[ai][bj][m][0] * alpha; b = b + acc[ai][bj][m][1] * alpha;
                    *(u32x4*)(HB + off) = pack8(a, b);
                    ss += (a[0] * a[0] + a[1] * a[1]) + (a[2] * a[2] + a[3] * a[3]) + (b[0] * b[0] + b[1] * b[1]) + (b[2] * b[2] + b[3] * b[3]); }
                ss += __shfl_xor(ss, 16); ss += __shfl_xor(ss, 32);
                if (fq == 0) unsafeAtomicAdd(ssq + row, ss); }
    }
};

struct EpiMixIn {
    static constexpr bool PERM = true, AFTER_DRAIN = false;
    bf16_t *CB, *CCX, *Q, *Kb; const float* ssq; float qscale;
    __device__ __forceinline__ void operator()(const f32x4 (&acc)[2][2][4][2], const Unit& u, int wr, int wc, int fr, int fq) const {
        const int row0 = u.pm * BM + wr * 64 + fr, pn = u.pn;
        float sv[2][4];
#pragma unroll
        for (int ai = 0; ai < 2; ++ai)
#pragma unroll
            for (int m = 0; m < 4; ++m) sv[ai][m] = ssq[row0 + ai * HALF + m * 16];
        if (pn >= 4 && pn < 12) {
            const int col0 = (pn - 4) * HALF + wc * 32 + 8 * fq;
#pragma unroll
            for (int ai = 0; ai < 2; ++ai)
#pragma unroll
                for (int m = 0; m < 4; ++m) { const int row = row0 + ai * HALF + m * 16; const float r = rs_of(sv[ai][m]), r2 = r * r;
                    *(u32x4*)(CCX + (size_t)row * 1024 + col0) = pack8(acc[ai][0][m][0] * acc[ai][1][m][0] * r2, acc[ai][0][m][1] * acc[ai][1][m][1] * r2); }
        } else {
            bf16_t* base; int colt; float sc = 1.f;
            if (pn < 4) { base = CB; colt = pn * BM; } else if (pn < 16) { base = Q; colt = (pn - 12) * BM; sc = qscale; } else { base = Kb; colt = (pn - 16) * BM; }
            const int col0 = colt + wc * 32 + 8 * fq;
#pragma unroll
            for (int ai = 0; ai < 2; ++ai)
#pragma unroll
                for (int m = 0; m < 4; ++m) { const int row = row0 + ai * HALF + m * 16; const float r = rs_of(sv[ai][m]) * sc;
#pragma unroll
                    for (int bj = 0; bj < 2; ++bj) *(u32x4*)(base + (size_t)row * 1024 + col0 + bj * HALF) = pack8(acc[ai][bj][m][0] * r, acc[ai][bj][m][1] * r); }
        }
    }
};

struct EpiVt {
    static constexpr bool PERM = true, AFTER_DRAIN = false;
    bf16_t* O; const float* ssq;
    __device__ __forceinline__ void operator()(const f32x4 (&acc)[2][2][4][2], const Unit& u, int wr, int wc, int fr, int fq) const {
        const int ch0 = u.pm * BM + wr * 64 + fr, tok0 = u.pn * BM + wc * 32 + 8 * fq;
        f32x4 sc[2][2];
#pragma unroll
        for (int bj = 0; bj < 2; ++bj)
#pragma unroll
            for (int n = 0; n < 2; ++n) {
                if (ssq) { const f32x4 s = *(const f32x4*)(ssq + tok0 + bj * HALF + 4 * n); sc[bj][n] = (f32x4){rs_of(s[0]), rs_of(s[1]), rs_of(s[2]), rs_of(s[3])}; }
                else sc[bj][n] = (f32x4){1.f, 1.f, 1.f, 1.f}; }
#pragma unroll
        for (int ai = 0; ai < 2; ++ai)
#pragma unroll
            for (int m = 0; m < 4; ++m) { const int ch = ch0 + ai * HALF + m * 16;
#pragma unroll
                for (int bj = 0; bj < 2; ++bj) { const int tok = tok0 + bj * HALF;
                    *(u32x4*)(O + ((size_t)(tok >> 11) * 1024 + ch) * 2048 + (tok & 2047)) = pack8(acc[ai][bj][m][0] * sc[bj][0], acc[ai][bj][m][1] * sc[bj][1]); } }
    }
};

template <int SIG> struct EpiGen {
    static constexpr bool PERM = true, AFTER_DRAIN = false;
    bf16_t* O; int ldc; const float* ssq; float sc; const float* bias;
    __device__ __forceinline__ void operator()(const f32x4 (&acc)[2][2][4][2], const Unit& u, int wr, int wc, int fr, int fq) const {
        const int row0 = u.pm * BM + wr * 64 + fr, col0 = u.pn * BM + wc * 32 + 8 * fq;
        f32x4 bv[2][2];
#pragma unroll
        for (int bj = 0; bj < 2; ++bj)
#pragma unroll
            for (int n = 0; n < 2; ++n) bv[bj][n] = bias ? *(const f32x4*)(bias + col0 + bj * HALF + 4 * n) : (f32x4){0.f, 0.f, 0.f, 0.f};
        float sv[2][4];
#pragma unroll
        for (int ai = 0; ai < 2; ++ai)
#pragma unroll
            for (int m = 0; m < 4; ++m) sv[ai][m] = ssq ? ssq[row0 + ai * HALF + m * 16] : 0.f;
#pragma unroll
        for (int ai = 0; ai < 2; ++ai)
#pragma unroll
            for (int m = 0; m < 4; ++m) { const int row = row0 + ai * HALF + m * 16; const float r = (ssq ? rs_of(sv[ai][m]) : 1.f) * sc;
#pragma unroll
                for (int bj = 0; bj < 2; ++bj) { f32x4 v0 = acc[ai][bj][m][0] * r + bv[bj][0], v1 = acc[ai][bj][m][1] * r + bv[bj][1];
                    if (SIG) {
#pragma unroll
                        for (int e = 0; e < 4; ++e) { v0[e] = sigmoid_f(v0[e]); v1[e] = sigmoid_f(v1[e]); } }
                    *(u32x4*)(O + (size_t)row * ldc + col0 + bj * HALF) = pack8(v0, v1); } }
    }
};

template <int ADD> struct EpiGateMul {
    static constexpr bool PERM = true, AFTER_DRAIN = false;
    bf16_t* G; const bf16_t* T;
    __device__ __forceinline__ void operator()(const f32x4 (&acc)[2][2][4][2], const Unit& u, int wr, int wc, int fr, int fq) const {
        const int row0 = u.pm * BM + wr * 64 + fr, col0 = u.pn * BM + wc * 32 + 8 * fq;
#pragma unroll
        for (int ai = 0; ai < 2; ++ai)
#pragma unroll
            for (int m = 0; m < 4; ++m) { const int row = row0 + ai * HALF + m * 16;
#pragma unroll
                for (int bj = 0; bj < 2; ++bj) { const size_t off = (size_t)row * 1024 + col0 + bj * HALF;
                    f32x4 g0, g1; unpack8(*(const u32x4*)(G + off), g0, g1);
                    f32x4 v0 = g0 * acc[ai][bj][m][0], v1 = g1 * acc[ai][bj][m][1];
                    if (ADD) { f32x4 t0, t1; unpack8(*(const u32x4*)(T + off), t0, t1); v0 = v0 + t0; v1 = v1 + t1; }
                    *(u32x4*)(G + off) = pack8(v0, v1); } }
    }
};

struct EpiFinal {
    static constexpr bool PERM = true, AFTER_DRAIN = false;
    const bf16_t* Hin; float* Out; float* ssq; float alpha; const float* gain; unsigned* cnt;
    __device__ __forceinline__ void operator()(const f32x4 (&acc_)[2][2][4][2], const Unit& u, int wr, int wc, int fr, int fq) const {
        f32x4 (&acc)[2][2][4][2] = const_cast<f32x4 (&)[2][2][4][2]>(acc_);
        const int row0 = u.pm * BM + wr * 64 + fr, col0 = u.pn * BM + wc * 32 + 8 * fq;
#pragma unroll
        for (int ai = 0; ai < 2; ++ai)
#pragma unroll
            for (int m = 0; m < 4; ++m) { const int row = row0 + ai * HALF + m * 16; float ss = 0.f;
#pragma unroll
                for (int bj = 0; bj < 2; ++bj) { const size_t off = (size_t)row * 1024 + col0 + bj * HALF;
                    f32x4 a, b; unpack8(*(const u32x4*)(Hin + off), a, b);
                    a = a + acc[ai][bj][m][0] * alpha; b = b + acc[ai][bj][m][1] * alpha;
                    acc[ai][bj][m][0] = a; acc[ai][bj][m][1] = b;
                    ss += (a[0] * a[0] + a[1] * a[1]) + (a[2] * a[2] + a[3] * a[3]) + (b[0] * b[0] + b[1] * b[1]) + (b[2] * b[2] + b[3] * b[3]); }
                ss += __shfl_xor(ss, 16); ss += __shfl_xor(ss, 32);
                if (fq == 0) unsafeAtomicAdd(ssq + row, ss); }
        asm volatile("s_waitcnt vmcnt(0)" ::: "memory");
        unsigned* pc = cnt + u.pm * 32;
        unsigned* pf = pc + 2048;
        if (fr == 0 && fq == 0) { if (__hip_atomic_fetch_add(pc, 1u, __ATOMIC_RELAXED, __HIP_MEMORY_SCOPE_AGENT) == 31u) __hip_atomic_store(pf, 1u, __ATOMIC_RELAXED, __HIP_MEMORY_SCOPE_AGENT); }
        { unsigned sp = 0; while (__hip_atomic_load(pf, __ATOMIC_RELAXED, __HIP_MEMORY_SCOPE_AGENT) == 0u && ++sp < (1u << 22)) __builtin_amdgcn_s_sleep(4); }
        f32x4 gv[2][2];
#pragma unroll
        for (int bj = 0; bj < 2; ++bj)
#pragma unroll
            for (int n = 0; n < 2; ++n) gv[bj][n] = *(const f32x4*)(gain + col0 + bj * HALF + 4 * n);
#pragma unroll
        for (int ai = 0; ai < 2; ++ai)
#pragma unroll
            for (int m = 0; m < 4; ++m) { const int row = row0 + ai * HALF + m * 16;
                const float r = rs_of(__hip_atomic_load(ssq + row, __ATOMIC_RELAXED, __HIP_MEMORY_SCOPE_AGENT));
#pragma unroll
                for (int bj = 0; bj < 2; ++bj) { const size_t off = (size_t)row * 1024 + col0 + bj * HALF;
                    __builtin_nontemporal_store(acc[ai][bj][m][0] * r * gv[bj][0], (f32x4*)(Out + off)); __builtin_nontemporal_store(acc[ai][bj][m][1] * r * gv[bj][1], (f32x4*)(Out + off + 4)); } }
    }
};

struct EpiTileC {
    static constexpr bool PERM = true, AFTER_DRAIN = false;
    bf16_t* O; const float* ssq; float sc; int swap;
    __device__ __forceinline__ void operator()(const f32x4 (&acc)[2][2][4][2], const Unit& u, int wr, int wc, int fr, int fq) const {
        const int tile = swap ? (u.pn * 4 + u.pm) : (u.pm * 4 + u.pn), rl0 = wr * 64 + fr, cl0 = wc * 32 + 8 * fq;
        bf16_t* base = O + (size_t)tile * 65536;
        float sv[2][4];
#pragma unroll
        for (int ai = 0; ai < 2; ++ai)
#pragma unroll
            for (int m = 0; m < 4; ++m) sv[ai][m] = ssq ? ssq[u.pm * BM + rl0 + ai * HALF + m * 16] : 0.f;
#pragma unroll
        for (int ai = 0; ai < 2; ++ai)
#pragma unroll
            for (int m = 0; m < 4; ++m) { const int rl = rl0 + ai * HALF + m * 16; const float r = (ssq ? rs_of(sv[ai][m]) : 1.f) * sc;
#pragma unroll
                for (int bj = 0; bj < 2; ++bj) *(u32x4*)(base + rl * 256 + cl0 + bj * HALF) = pack8(acc[ai][bj][m][0] * r, acc[ai][bj][m][1] * r); }
    }
};
struct EpiSoftmaxP {
    static constexpr bool PERM = true, AFTER_DRAIN = true;
    bf16_t* Pm; float* rsum;
    __device__ __forceinline__ void fused(const f32x4 (&acc)[2][2][4][2], const Unit& u, int wr, int wc, int fr, int fq, PG8_LAS unsigned char* lds, int, int) const {
        PG8_LAS float* red = (PG8_LAS float*)lds;
        const int rl0 = wr * 64 + fr, cl0 = wc * 32 + 8 * fq;
        float mx[2][4];
#pragma unroll
        for (int ai = 0; ai < 2; ++ai)
#pragma unroll
            for (int m = 0; m < 4; ++m) { float v = acc[ai][0][m][0][0];
#pragma unroll
                for (int bj = 0; bj < 2; ++bj)
#pragma unroll
                    for (int n = 0; n < 2; ++n)
#pragma unroll
                        for (int e = 0; e < 4; ++e) v = __builtin_fmaxf(v, acc[ai][bj][m][n][e]);
                v = __builtin_fmaxf(v, __shfl_xor(v, 16)); v = __builtin_fmaxf(v, __shfl_xor(v, 32));
                if (fq == 0) red[(rl0 + ai * HALF + m * 16) * 4 + wc] = v; }
        __syncthreads();
#pragma unroll
        for (int ai = 0; ai < 2; ++ai)
#pragma unroll
            for (int m = 0; m < 4; ++m) { const f32x4 t = *(const PG8_LAS f32x4*)(red + (rl0 + ai * HALF + m * 16) * 4); mx[ai][m] = __builtin_fmaxf(__builtin_fmaxf(t[0], t[1]), __builtin_fmaxf(t[2], t[3])); }
        __syncthreads();
        bf16_t* base = Pm + (size_t)u.pm * 65536;
#pragma unroll
        for (int ai = 0; ai < 2; ++ai)
#pragma unroll
            for (int m = 0; m < 4; ++m) { const int rl = rl0 + ai * HALF + m * 16; float sm = 0.f;
#pragma unroll
                for (int bj = 0; bj < 2; ++bj) { f32x4 p0, p1;
#pragma unroll
                    for (int e = 0; e < 4; ++e) { p0[e] = __builtin_amdgcn_exp2f(acc[ai][bj][m][0][e] - mx[ai][m]); p1[e] = __builtin_amdgcn_exp2f(acc[ai][bj][m][1][e] - mx[ai][m]); }
                    sm += (p0[0] + p0[1]) + (p0[2] + p0[3]) + (p1[0] + p1[1]) + (p1[2] + p1[3]);
                    *(u32x4*)(base + rl * 256 + cl0 + bj * HALF) = pack8(p0, p1); }
                sm += __shfl_xor(sm, 16); sm += __shfl_xor(sm, 32);
                if (fq == 0) red[rl * 4 + wc] = sm; }
        __syncthreads();
        if (wc == 0 && fq == 0) {
#pragma unroll
            for (int ai = 0; ai < 2; ++ai)
#pragma unroll
                for (int m = 0; m < 4; ++m) { const int rl = rl0 + ai * HALF + m * 16; const f32x4 t = *(const PG8_LAS f32x4*)(red + rl * 4); rsum[u.pm * 256 + rl] = (t[0] + t[1]) + (t[2] + t[3]); }
        }
    }
};
struct EpiO {
    static constexpr bool PERM = true, AFTER_DRAIN = false;
    bf16_t* OX; const float* rsum;
    __device__ __forceinline__ void operator()(const f32x4 (&acc)[2][2][4][2], const Unit& u, int wr, int wc, int fr, int fq) const {
        const int rl0 = wr * 64 + fr, cl0 = wc * 32 + 8 * fq, hx = u.pm & 3, row0 = (u.pm >> 2) * BM;
        float sv[2][4];
#pragma unroll
        for (int ai = 0; ai < 2; ++ai)
#pragma unroll
            for (int m = 0; m < 4; ++m) sv[ai][m] = rsum[u.pm * 256 + rl0 + ai * HALF + m * 16];
#pragma unroll
        for (int ai = 0; ai < 2; ++ai)
#pragma unroll
            for (int m = 0; m < 4; ++m) { const int rl = rl0 + ai * HALF + m * 16; const float r = __builtin_amdgcn_rcpf(sv[ai][m]);
#pragma unroll
                for (int bj = 0; bj < 2; ++bj) *(u32x4*)(OX + (size_t)(row0 + rl) * 1024 + hx * 256 + cl0 + bj * HALF) = pack8(acc[ai][bj][m][0] * r, acc[ai][bj][m][1] * r); }
    }
};
struct OrderOne {
    int tA, tB;
    __device__ __forceinline__ bool next(int i, Unit& u) const { if (i > 0) return false; u.pm = tA; u.pn = tB; u.job = 0; return true; }
    __device__ __forceinline__ const char* baseA(const Gemm& g, const Unit&) const { return (const char*)g.A; }
    __device__ __forceinline__ const char* baseB(const Gemm& g, const Unit&) const { return (const char*)g.Bt; }
    __device__ __forceinline__ void a_ready(const Unit&) const {}
    __device__ __forceinline__ void done(const Unit&) const {}
};

template <class Epi, class Sched, bool ALIGN_EPI = false, bool SP2 = false>
__device__ __forceinline__ void gemm_phase(PG8_LAS unsigned char* lds, const Gemm g, const Sched& S, const Epi& E) {
    int tid_o = threadIdx.x; asm volatile("" : "+v"(tid_o));
    const int tid = tid_o, wid = __builtin_amdgcn_readfirstlane(tid >> 6), lane = tid & 63, wr = wid >> 2, wc = wid & 3, fr = lane & 15, fq = lane >> 4;
    const int K = g.K, nt = K / BK;
    unsigned voffA[2], voffB[2];
#pragma unroll
    for (int i = 0; i < 2; ++i) { int R, C; stage_rc(tid * 16 + i * 8192, R, C); const int Rb = Epi::PERM ? ((R & ~31) + perm32(R & 31)) : R;
        voffA[i] = (unsigned)(R * K + C) * 2u; voffB[i] = (unsigned)(Rb * K + C) * 2u; }
    const size_t kstep = (size_t)(BK * 2);
    const size_t hstep = (size_t)HALF * K * 2;
    const size_t tstep = 2 * hstep;
    const unsigned ldsw = (unsigned)wid * 1024u;
    const int aoff = lds_byte(wr * 64 + fr, fq * 8), boff = lds_byte(wc * 32 + fr, fq * 8);
#define PG8_SA(b, h) (((b) * 2 + (h)) * HTB)
#define PG8_SB(b, h) ((4 + (b) * 2 + (h)) * HTB)
#define PG8_STAGE(bufoff, gbase, voff) do { _Pragma("unroll") for (int _i = 0; _i < 2; ++_i) \
        __builtin_amdgcn_global_load_lds((const unsigned*)((const char*)(gbase) + (voff)[_i]), (PG8_LAS unsigned*)(lds + (bufoff) + ldsw + _i * 8192), 16, 0, 0); } while (0)
#define PG8_LDA(dst, b, h) do { _Pragma("unroll") for (int m = 0; m < 4; ++m) _Pragma("unroll") for (int k = 0; k < 2; ++k) dst[m][k] = *(const PG8_LAS bf16x8*)(lds + PG8_SA(b, h) + aoff + m * 2048 + k * 1024); } while (0)
#define PG8_LDB(dst, b, h) do { _Pragma("unroll") for (int n = 0; n < 2; ++n) _Pragma("unroll") for (int k = 0; k < 2; ++k) dst[n][k] = *(const PG8_LAS bf16x8*)(lds + PG8_SB(b, h) + boff + n * 2048 + k * 1024); } while (0)
#define PG8_MMA(ai, bj, At, Bt) do { __builtin_amdgcn_s_setprio(1); _Pragma("unroll") for (int m = 0; m < 4; ++m) _Pragma("unroll") for (int n = 0; n < 2; ++n) _Pragma("unroll") for (int k = 0; k < 2; ++k) \
        acc[ai][bj][m][n] = __builtin_amdgcn_mfma_f32_16x16x32_bf16(Bt[n][k], At[m][k], acc[ai][bj][m][n], 0, 0, 0); __builtin_amdgcn_s_setprio(0); } while (0)
#define PG8_WAIT_V(n) asm volatile("s_waitcnt vmcnt(" #n ")" ::: "memory")
#define PG8_WAIT_L(n) asm volatile("s_waitcnt lgkmcnt(" #n ")" ::: "memory")
#define PG8_BAR __builtin_amdgcn_s_barrier()
#define PG8_SCHED __builtin_amdgcn_sched_barrier(0)
    Unit cur, nxt; int ui = 0;
    if (!S.next(0, cur)) return;
    f32x4 acc[2][2][4][2];
#pragma unroll
    for (int a = 0; a < 2; ++a)
#pragma unroll
        for (int b = 0; b < 2; ++b)
#pragma unroll
            for (int m = 0; m < 4; ++m)
#pragma unroll
                for (int n = 0; n < 2; ++n) acc[a][b][m][n] = (f32x4){0.f, 0.f, 0.f, 0.f};
    bf16x8 At[4][2], B0[2][2], B1[2][2];
    const char* cA = S.baseA(g, cur) + (size_t)cur.pm * tstep; const char* cB = S.baseB(g, cur) + (size_t)cur.pn * tstep;
    S.a_ready(cur);
    if constexpr (SP2) {
        PG8_STAGE(PG8_SB(0, 0), cB, voffB); PG8_STAGE(PG8_SB(0, 1), cB + hstep, voffB); PG8_STAGE(PG8_SA(0, 0), cA, voffA); PG8_STAGE(PG8_SA(0, 1), cA + hstep, voffA);
        if (wr == 1) PG8_BAR;
        PG8_WAIT_V(2); PG8_BAR;
        PG8_STAGE(PG8_SB(1, 0), cB + kstep, voffB); PG8_STAGE(PG8_SA(1, 0), cA + kstep, voffA); PG8_STAGE(PG8_SB(1, 1), cB + hstep + kstep, voffB);
        PG8_WAIT_V(6); PG8_BAR;
    } else {
        PG8_STAGE(PG8_SB(0, 0), cB, voffB); PG8_STAGE(PG8_SA(0, 0), cA, voffA); PG8_STAGE(PG8_SB(0, 1), cB + hstep, voffB); PG8_STAGE(PG8_SA(0, 1), cA + hstep, voffA);
        if (wr == 1) PG8_BAR;
        PG8_WAIT_V(4); PG8_BAR;
        PG8_STAGE(PG8_SB(1, 0), cB + kstep, voffB); PG8_STAGE(PG8_SA(1, 0), cA + kstep, voffA); PG8_STAGE(PG8_SB(1, 1), cB + hstep + kstep, voffB);
        PG8_WAIT_V(6); PG8_BAR;
    }
    for (;;) {
        const bool has_next = S.next(ui + 1, nxt);
        const char* nA = has_next ? S.baseA(g, nxt) + (size_t)nxt.pm * tstep : cA; const char* nB = has_next ? S.baseB(g, nxt) + (size_t)nxt.pn * tstep : cB;
        for (int t = 0; t < nt; t += 2) {
            const bool last = (t == nt - 2);
            const char* a1 = cA + (size_t)(t + 1) * kstep;
            const char* a2 = last ? nA : cA + (size_t)(t + 2) * kstep; const char* b2 = last ? nB : cB + (size_t)(t + 2) * kstep;
            const char* a3 = a2 + kstep; const char* b3 = b2 + kstep;
            if (last && has_next) S.a_ready(nxt);
            if constexpr (SP2) {
            PG8_LDB(B0, 0, 0); PG8_LDB(B1, 0, 1); PG8_SCHED; PG8_LDA(At, 0, 0); PG8_STAGE(PG8_SA(1, 1), a1 + hstep, voffA);
            PG8_WAIT_V(8); PG8_WAIT_L(0); PG8_BAR; PG8_MMA(0, 0, At, B0); PG8_MMA(0, 1, At, B1); PG8_BAR; PG8_SCHED;
            PG8_LDA(At, 0, 1); PG8_STAGE(PG8_SB(0, 0), b2, voffB); PG8_STAGE(PG8_SB(0, 1), b2 + hstep, voffB); PG8_STAGE(PG8_SA(0, 0), a2, voffA);
            PG8_WAIT_V(8); PG8_WAIT_L(0); PG8_BAR; PG8_MMA(1, 0, At, B0); PG8_MMA(1, 1, At, B1); PG8_BAR; PG8_SCHED;
            PG8_LDB(B0, 1, 0); PG8_LDB(B1, 1, 1); PG8_SCHED; PG8_LDA(At, 1, 0); PG8_STAGE(PG8_SA(0, 1), a2 + hstep, voffA);
            PG8_WAIT_V(8); PG8_WAIT_L(0); PG8_BAR; PG8_MMA(0, 0, At, B0); PG8_MMA(0, 1, At, B1); PG8_BAR; PG8_SCHED;
            PG8_LDA(At, 1, 1); PG8_STAGE(PG8_SB(1, 0), b3, voffB); PG8_STAGE(PG8_SB(1, 1), b3 + hstep, voffB); PG8_STAGE(PG8_SA(1, 0), a3, voffA);
            PG8_WAIT_V(8); PG8_WAIT_L(0); PG8_BAR; PG8_MMA(1, 0, At, B0); PG8_MMA(1, 1, At, B1); PG8_BAR; PG8_SCHED;
            } else {
            PG8_LDB(B0, 0, 0); PG8_SCHED; PG8_LDA(At, 0, 0); PG8_STAGE(PG8_SA(1, 1), a1 + hstep, voffA);
            PG8_WAIT_L(8); PG8_BAR; PG8_WAIT_L(0); PG8_MMA(0, 0, At, B0); PG8_BAR; PG8_SCHED;
            PG8_LDB(B1, 0, 1); PG8_STAGE(PG8_SB(0, 0), b2, voffB);
            PG8_BAR; PG8_WAIT_L(0); PG8_MMA(0, 1, At, B1); PG8_BAR;
            PG8_LDA(At, 0, 1); PG8_STAGE(PG8_SA(0, 0), a2, voffA);
            PG8_BAR; PG8_WAIT_L(0); PG8_MMA(1, 0, At, B0); PG8_BAR; PG8_SCHED;
            PG8_STAGE(PG8_SB(0, 1), b2 + hstep, voffB);
            PG8_WAIT_V(6); PG8_BAR; PG8_MMA(1, 1, At, B1); PG8_BAR;
            PG8_LDB(B0, 1, 0); PG8_SCHED; PG8_LDA(At, 1, 0); PG8_STAGE(PG8_SA(0, 1), a2 + hstep, voffA);
            PG8_WAIT_L(8); PG8_BAR; PG8_WAIT_L(0); PG8_MMA(0, 0, At, B0); PG8_BAR; PG8_SCHED;
            PG8_LDB(B1, 1, 1); PG8_STAGE(PG8_SB(1, 0), b3, voffB);
            PG8_BAR; PG8_WAIT_L(0); PG8_MMA(0, 1, At, B1); PG8_BAR;
            PG8_LDA(At, 1, 1); PG8_STAGE(PG8_SA(1, 0), a3, voffA);
            PG8_BAR; PG8_WAIT_L(0); PG8_MMA(1, 0, At, B0); PG8_BAR; PG8_SCHED;
            PG8_STAGE(PG8_SB(1, 1), b3 + hstep, voffB);
            PG8_WAIT_V(6); PG8_BAR; PG8_MMA(1, 1, At, B1); PG8_BAR;
            }
        }
        if constexpr (ALIGN_EPI) { if (wr == 0) PG8_BAR; }
        if constexpr (!Epi::AFTER_DRAIN) { E(acc, cur, wr, wc, fr, fq); S.done(cur); }
        if (!has_next) break;
#pragma unroll
        for (int a = 0; a < 2; ++a)
#pragma unroll
            for (int b = 0; b < 2; ++b)
#pragma unroll
                for (int m = 0; m < 4; ++m)
#pragma unroll
                    for (int n = 0; n < 2; ++n) acc[a][b][m][n] = (f32x4){0.f, 0.f, 0.f, 0.f};
        cur = nxt; cA = nA; cB = nB; ++ui;
        if constexpr (ALIGN_EPI) { if (wr == 1) PG8_BAR; }
    }
    PG8_WAIT_V(0);
    if constexpr (!ALIGN_EPI) { if (wr == 0) PG8_BAR; }
    PG8_BAR;
    if constexpr (Epi::AFTER_DRAIN) { E.fused(acc, cur, wr, wc, fr, fq, lds, wid, lane); S.done(cur); }
#undef PG8_SA
#undef PG8_SB
#undef PG8_STAGE
#undef PG8_LDA
#undef PG8_LDB
#undef PG8_MMA
#undef PG8_WAIT_V
#undef PG8_WAIT_L
#undef PG8_BAR
#undef PG8_SCHED
}
}

constexpr int NWAVES = 8, NTHREADS = NWAVES * 64;
constexpr int BATCH = 8, SEQ = 2048, DM = 1024, M = BATCH * SEQ, DFF = 2816, MEMLEN = 256, MM = BATCH * MEMLEN;
constexpr int NIN = 8192;
constexpr float QSCALE_SB = 0.08838834764831845f * 1.4426950408889634f;
constexpr float QSCALE_X = 0.0625f * 1.4426950408889634f;

constexpr size_t KiB = 1024, MiB = 1u << 20;
constexpr size_t WS_WGU = 0;
constexpr size_t WS_WD = 11 * MiB;
constexpr size_t WS_WIN = WS_WD + 5632 * KiB;
constexpr size_t WS_WCO = WS_WIN + 16 * MiB;
constexpr size_t WS_WAO = WS_WCO + 2 * MiB;
constexpr size_t WS_WO = WS_WAO + 2 * MiB;
constexpr size_t WS_WCQ = WS_WO + 2 * MiB;
constexpr size_t WS_WCKV = WS_WCQ + 2 * MiB;
constexpr size_t WS_WXO = WS_WCKV + 4 * MiB;
constexpr size_t WS_MN = WS_WXO + 2 * MiB;
constexpr size_t WS_KX = WS_MN + 4 * MiB;
constexpr size_t WS_VXT = WS_KX + 4 * MiB;
constexpr size_t WS_SSQ = WS_VXT + 4 * MiB;
constexpr size_t WS_S0 = WS_SSQ + 512 * KiB;
constexpr size_t SLOT = 32 * MiB;
constexpr size_t WS_END = WS_S0 + 6 * SLOT;
static_assert(WS_END + 32768 <= 256 * MiB, "d_ws map");

constexpr int LDS_RING = 139264, LDS_BYTES = LDS_RING + 64;
constexpr size_t WS_BAR = WS_END, BAR_BYTES = 65536;
constexpr size_t WS_RSUM = WS_BAR + BAR_BYTES;
static_assert(WS_RSUM + 262144 <= 256 * MiB, "d_ws map");
constexpr size_t WS_PANEL = WS_BAR + 32768;

#define GAS __attribute__((address_space(1)))
#define LAS __attribute__((address_space(3)))
#define DI __device__ __forceinline__
typedef unsigned short bf16;
typedef unsigned u32x4 __attribute__((ext_vector_type(4)));
typedef unsigned u32x2 __attribute__((ext_vector_type(2)));
typedef float f32x4 __attribute__((ext_vector_type(4)));
typedef float f32x16 __attribute__((ext_vector_type(16)));
typedef short bf16x8 __attribute__((ext_vector_type(8)));
#define LDS_WAIT() asm volatile("s_waitcnt lgkmcnt(0)" ::: "memory")
#define MFMA32(a, b, c) __builtin_amdgcn_mfma_f32_32x32x16_bf16((a), (b), (c), 0, 0, 0)
using pg8::cvt_pk_bf16; using pg8::pack8; using pg8::unpack8; using pg8::rs_of;

DI float wave_sum(float v) {
#pragma unroll
    for (int o = 1; o < 64; o <<= 1) v += __shfl_xor(v, o);
    return v;
}

DI void tr_load(float (&wv)[32], const float* W, int N, int k0, int n0, int lane) {
    const float* wp = W + (size_t)(k0 + (lane >> 5)) * N + n0 + (lane & 31);
#pragma unroll
    for (int i = 0; i < 32; ++i) wv[i] = __builtin_nontemporal_load(wp + (size_t)(2 * i) * N);
}
DI void tr_finish(float (&wv)[32], int K, bf16* WT, int dst_row0, const float* gain, LAS float* scr, int k0, int lane) {
    if (gain) {
#pragma unroll
        for (int i = 0; i < 32; ++i) wv[i] *= gain[k0 + 2 * i + (lane >> 5)];
    }
#pragma unroll
    for (int i = 0; i < 32; ++i) scr[(2 * i + (lane >> 5)) * 33 + (lane & 31)] = wv[i];
    LDS_WAIT(); asm volatile("" ::: "memory");
    const int c = lane & 7;
#pragma unroll
    for (int j = 0; j < 4; ++j) { const int n = (lane >> 3) + 8 * j; const LAS float* s = scr + (8 * c) * 33 + n;
        u32x4 o; o.x = cvt_pk_bf16(s[0 * 33], s[1 * 33]); o.y = cvt_pk_bf16(s[2 * 33], s[3 * 33]); o.z = cvt_pk_bf16(s[4 * 33], s[5 * 33]); o.w = cvt_pk_bf16(s[6 * 33], s[7 * 33]);
        *(u32x4*)(WT + (size_t)(dst_row0 + n) * K + k0 + 8 * c) = o; }
    LDS_WAIT(); asm volatile("" ::: "memory");
}
template <int MAP> DI int map_row(int n0) {
    if (MAP == 1) { const int j = n0 < DFF ? n0 : n0 - DFF; return (j >> 7) * 256 + (n0 < DFF ? 0 : 128) + (j & 127); }
    if (MAP == 2) { if (n0 >= 1024 && n0 < 3072) { const int j = (n0 - 1024) & 1023; return 1024 + (j >> 7) * 256 + (n0 < 2048 ? 0 : 128) + (j & 127); } return n0; }
    return n0;
}
template <int MAP> DI void convert_weight(const float* W, int K, int N, bf16* WT, const float* gain, LAS float* scr, int gw, int ngw, int lane) {
    const int nblk = N / 32, items = (K / 64) * nblk;
    int it = gw; if (it >= items) return;
    float ra[32], rb[32];
    tr_load(ra, W, N, 64 * (it / nblk), 32 * (it % nblk), lane);
    for (;;) {
        int nx = it + ngw; bool hn = nx < items;
        if (hn) tr_load(rb, W, N, 64 * (nx / nblk), 32 * (nx % nblk), lane);
        tr_finish(ra, K, WT, map_row<MAP>(32 * (it % nblk)), gain, scr, 64 * (it / nblk), lane);
        if (!hn) break;
        it = nx; nx = it + ngw; hn = nx < items;
        if (hn) tr_load(ra, W, N, 64 * (nx / nblk), 32 * (nx % nblk), lane);
        tr_finish(rb, K, WT, map_row<MAP>(32 * (it % nblk)), gain, scr, 64 * (it / nblk), lane);
        if (!hn) break;
        it = nx;
    }
}

struct CvtItem { const float* W; bf16* WT; const float* gain; int K, N, map, it; };
template <int LIST> DI bool cvt_decode(int g, const float* const* in, unsigned char* ws, CvtItem& c);
DI void cvt_load(float (&r)[32], const CvtItem& c, int lane) { const int nblk = c.N >> 5; tr_load(r, c.W, c.N, 64 * (c.it / nblk), 32 * (c.it % nblk), lane); }
DI void cvt_finish(float (&r)[32], const CvtItem& c, LAS float* scr, int lane) { const int nblk = c.N >> 5, n0 = 32 * (c.it % nblk);
    const int dst = c.map == 1 ? map_row<1>(n0) : c.map == 2 ? map_row<2>(n0) : n0; tr_finish(r, c.K, c.WT, dst, c.gain, scr, 64 * (c.it / nblk), lane); }
template <int LIST> DI void convert_list(const float* const* in, unsigned char* ws, LAS float* scr, int gw, int ngw, int lane) {
    int g = gw; CvtItem ca, cb; if (!cvt_decode<LIST>(g, in, ws, ca)) return;
    float ra[32], rb[32];
    cvt_load(ra, ca, lane);
    for (;;) {
        bool hn = cvt_decode<LIST>(g + ngw, in, ws, cb);
        if (hn) cvt_load(rb, cb, lane);
        cvt_finish(ra, ca, scr, lane);
        if (!hn) break;
        g += ngw; hn = cvt_decode<LIST>(g + ngw, in, ws, ca);
        if (hn) cvt_load(ra, ca, lane);
        cvt_finish(rb, cb, scr, lane);
        if (!hn) break;
        g += ngw;
    }
}

DI int crow(int i, int h) { return (i & 3) + 8 * (i >> 2) + 4 * h; }
constexpr int SB_KROW = 272, SB_VROW = 72, SB_KB = 32 * SB_KROW, SB_VB = 128 * SB_VROW, SB_BUF = SB_KB + SB_VB;

DI void sb_unit(LAS unsigned char* lds, bf16* Q  , const bf16* Kb, const bf16* Vt, int b, int hh, int qb, int tid, int wave, int lane) {
    const int r = lane & 31, h = lane >> 5, q0 = qb * 256;
    bf16* qp = Q + (size_t)(b * SEQ + q0 + wave * 32 + r) * 1024 + hh * 128;
    bf16x8 qf[8];
#pragma unroll
    for (int s = 0; s < 8; ++s) qf[s] = *(const bf16x8*)(qp + 16 * s + 8 * h);
    f32x16 o[4];
#pragma unroll
    for (int d = 0; d < 4; ++d)
#pragma unroll
        for (int i = 0; i < 16; ++i) o[d][i] = 0.f;
    float carry = 1.f; bool alive = true;
    volatile LAS int* fl = (volatile LAS int*)(lds + 2 * SB_BUF);
    const int nkt = (q0 + 256) / 32, dt = qb * 8 + wave;
    const int kr_ = tid >> 4, kch = tid & 15;
    const bf16* kg = Kb + (size_t)(b * SEQ + kr_) * 1024 + hh * 128 + kch * 8;
    const unsigned kl = kr_ * SB_KROW + kch * 16;
    const int vd = tid >> 2, vch = tid & 3;
    const bf16* vg = Vt + ((size_t)(b * 8 + hh) * 128 + vd) * SEQ + vch * 8;
    const unsigned vl = SB_KB + vd * SB_VROW + vch * 16;
    u32x4 kreg = *(const u32x4*)(kg + (size_t)(nkt - 1) * 32 * 1024), vreg = *(const u32x4*)(vg + (nkt - 1) * 32);
    *(LAS u32x4*)(lds + kl) = kreg; *(LAS u32x2*)(lds + vl) = (u32x2){vreg.x, vreg.y}; *(LAS u32x2*)(lds + vl + 8) = (u32x2){vreg.z, vreg.w};
    __syncthreads();
    for (int kt = nkt - 1; kt >= 0; --kt) {
        const int cur = (nkt - 1 - kt) & 1;
        LAS unsigned char* kb = lds + cur * SB_BUF; LAS unsigned char* vb = kb + SB_KB;
        if (kt > 0) { kreg = *(const u32x4*)(kg + (size_t)(kt - 1) * 32 * 1024); vreg = *(const u32x4*)(vg + (kt - 1) * 32); }
        if (kt <= dt && alive) {
            f32x16 x;
#pragma unroll
            for (int i = 0; i < 16; ++i) x[i] = 0.f;
#pragma unroll
            for (int s = 0; s < 8; ++s) { const bf16x8 a = *(const LAS bf16x8*)(kb + r * SB_KROW + (16 * s + 8 * h) * 2); x = MFMA32(a, qf[s], x); }
            float bt[16], om[16];
#pragma unroll
            for (int i = 0; i < 16; ++i) { const float e = __builtin_amdgcn_exp2f(-x[i]); const float bb = __builtin_amdgcn_rcpf(1.f + e); bt[i] = bb; om[i] = 1.f - bb; }
            if (kt == dt) {
#pragma unroll
                for (int i = 0; i < 16; ++i) { const bool valid = crow(i, h) < r; bt[i] = valid ? bt[i] : 0.f; om[i] = valid ? om[i] : 1.f; }
            }
            float G[4], PG[4];
#pragma unroll
            for (int m = 0; m < 4; ++m) { G[m] = (om[4 * m] * om[4 * m + 1]) * (om[4 * m + 2] * om[4 * m + 3]); PG[m] = __shfl_xor(G[m], 32); }
            const float T0 = G[0] * PG[0], T1 = G[1] * PG[1], T2 = G[2] * PG[2], T3 = G[3] * PG[3];
            float R[4]; R[3] = 1.f; R[2] = T3; R[1] = T3 * T2; R[0] = R[1] * T1;
            const float total = R[0] * T0;
            float p[16];
#pragma unroll
            for (int m = 0; m < 4; ++m) { float a = carry * R[m] * (h == 0 ? PG[m] : 1.f);
                p[4 * m + 3] = bt[4 * m + 3] * a; a *= om[4 * m + 3];
                p[4 * m + 2] = bt[4 * m + 2] * a; a *= om[4 * m + 2];
                p[4 * m + 1] = bt[4 * m + 1] * a; a *= om[4 * m + 1];
                p[4 * m + 0] = bt[4 * m + 0] * a; }
            carry *= total;
            alive = __builtin_amdgcn_ballot_w64(carry != 0.f) != 0ull;
            u32x4 w0, w1;
            w0.x = cvt_pk_bf16(p[0], p[1]); w0.y = cvt_pk_bf16(p[2], p[3]); w0.z = cvt_pk_bf16(p[4], p[5]); w0.w = cvt_pk_bf16(p[6], p[7]);
            w1.x = cvt_pk_bf16(p[8], p[9]); w1.y = cvt_pk_bf16(p[10], p[11]); w1.z = cvt_pk_bf16(p[12], p[13]); w1.w = cvt_pk_bf16(p[14], p[15]);
            const bf16x8 pf0 = __builtin_bit_cast(bf16x8, w0), pf1 = __builtin_bit_cast(bf16x8, w1);
#pragma unroll
            for (int db = 0; db < 4; ++db)
#pragma unroll
                for (int s = 0; s < 2; ++s) { const LAS unsigned char* vp = vb + (32 * db + r) * SB_VROW + (16 * s + 4 * h) * 2;
                    const u32x2 lo = *(const LAS u32x2*)vp, hi = *(const LAS u32x2*)(vp + 16);
                    const u32x4 av = {lo.x, lo.y, hi.x, hi.y};
                    o[db] = MFMA32(__builtin_bit_cast(bf16x8, av), s ? pf1 : pf0, o[db]); }
        }
        if (kt > 0) { LAS unsigned char* nb = lds + (cur ^ 1) * SB_BUF;
            *(LAS u32x4*)(nb + kl) = kreg; *(LAS u32x2*)(nb + vl) = (u32x2){vreg.x, vreg.y}; *(LAS u32x2*)(nb + vl + 8) = (u32x2){vreg.z, vreg.w}; }
        if (lane == 0) fl[cur * 8 + wave] = (kt <= dt && !alive) ? 1 : 0;
        __syncthreads();
        { int nd = 0;
#pragma unroll
          for (int w = 0; w < 8; ++w) nd += fl[cur * 8 + w];
          if (nd == 8) break; }
    }
#pragma unroll
    for (int db = 0; db < 4; ++db)
#pragma unroll
        for (int g = 0; g < 4; ++g) { u32x2 w; w.x = cvt_pk_bf16(o[db][4 * g], o[db][4 * g + 1]); w.y = cvt_pk_bf16(o[db][4 * g + 2], o[db][4 * g + 3]);
            *(u32x2*)(qp + 32 * db + 8 * g + 4 * h) = w; }
}

static_assert(2 * SB_BUF + 64 <= LDS_RING, "attention LDS");

#define XB_TMO      128
#define XB_XCNT(j)  (256  + 64 * (j))
#define XB_XSUB(j)  (1280 + 64 * (j))
#define XB_XGEN(j)  (2304 + 64 * (j))
#define XB_TOP      3328
#define XB_TOPGEN   3392
#define XCD_BAR_WORDS 3456
#define XB_SPIN_CAP (1u << 18)

__device__ __forceinline__ unsigned xb_ld(unsigned* p)              { return __hip_atomic_load(p, __ATOMIC_RELAXED, __HIP_MEMORY_SCOPE_AGENT); }
__device__ __forceinline__ unsigned xb_add(unsigned* p, unsigned v) { return __hip_atomic_fetch_add(p, v, __ATOMIC_RELAXED, __HIP_MEMORY_SCOPE_AGENT); }
__device__ __forceinline__ unsigned xb_xcc_id() { return (unsigned)__builtin_amdgcn_s_getreg((3 << 11) | 20) & 0xFu; }
#define XB_SPIN(cond, bar) do { unsigned _sp = 0; while (cond) { __builtin_amdgcn_s_sleep(4); \
    if ((++_sp & 255u) == 0u) { if (xb_ld(&(bar)[XB_TMO])) break; if (_sp > XB_SPIN_CAP) { atomicAdd(&(bar)[XB_TMO], 1u); break; } } } } while (0)

struct XcdBarrier {
    unsigned* bar; unsigned x;
    volatile LAS unsigned* st;
};

__device__ __forceinline__ XcdBarrier xcd_barrier_post(unsigned* bar, volatile LAS unsigned* st) {
    XcdBarrier b; b.bar = bar; b.x = xb_xcc_id(); b.st = st;
    if (threadIdx.x == 0) (void)xb_add(&bar[XB_XCNT(b.x)], 1u);
    return b;
}
__device__ __forceinline__ void xcd_barrier_complete(unsigned* bar, unsigned x, unsigned& nloc, unsigned& nx) {
    const unsigned G = gridDim.x * gridDim.y * gridDim.z;
    unsigned sum, cnt, mine, sp = 0u;
    for (;;) {
        sum = 0u; cnt = 0u; mine = 0u;
#pragma unroll
        for (unsigned j = 0; j < 16; ++j) { const unsigned c = xb_ld(&bar[XB_XCNT(j)]); sum += c; cnt += (c > 0u) ? 1u : 0u; mine = (j == x) ? c : mine; }
        if (sum == G) break;
        __builtin_amdgcn_s_sleep(1);
        if ((++sp & 255u) == 0u) { if (xb_ld(&bar[XB_TMO])) break; if (sp > XB_SPIN_CAP) { atomicAdd(&bar[XB_TMO], 1u); break; } }
    }
    nloc = mine > 0u ? mine : 1u; nx = cnt > 0u ? cnt : 1u;
}

__device__ __forceinline__ void xcd_barrier(const XcdBarrier& b) {
    asm volatile("s_waitcnt vmcnt(0)" ::: "memory");
    __syncthreads();
    if (threadIdx.x == 0) {
        unsigned* bar = b.bar;
        __builtin_amdgcn_s_waitcnt(0);
        unsigned nloc = b.st[0], nx = b.st[1];
        if (nloc == 0u) { xcd_barrier_complete(bar, b.x, nloc, nx); b.st[0] = nloc; b.st[1] = nx; }
        const unsigned old = xb_add(&bar[XB_XSUB(b.x)], 1u);
        const unsigned gen = old / nloc;
        if (old + 1u == (gen + 1u) * nloc) {
            __builtin_amdgcn_fence(__ATOMIC_RELEASE, "agent");
            asm volatile("s_waitcnt vmcnt(0)" ::: "memory");
            const unsigned og = xb_add(&bar[XB_TOP], 1u);
            const unsigned tg = og / nx;
            if (og + 1u == (tg + 1u) * nx) xb_add(&bar[XB_TOPGEN], 1u);
            else XB_SPIN(xb_ld(&bar[XB_TOPGEN]) == tg, bar);
            __builtin_amdgcn_fence(__ATOMIC_ACQUIRE, "agent");
            xb_add(&bar[XB_XGEN(b.x)], 1u);
            asm volatile("s_waitcnt vmcnt(0)" ::: "memory");
        } else {
            XB_SPIN(xb_ld(&bar[XB_XGEN(b.x)]) == gen, bar);
            __builtin_amdgcn_fence(__ATOMIC_ACQUIRE, "agent");
            asm volatile("s_waitcnt vmcnt(0)" ::: "memory");
        }
    }
    __syncthreads();
}

#define XL_SUB(j) (5120 + 64 * (j))
#define XL_GEN(j) (6144 + 64 * (j))
#define XL_BAD 7168
__device__ __forceinline__ void xcd_local_barrier(const XcdBarrier& b) {
    asm volatile("s_waitcnt vmcnt(0)" ::: "memory");
    __syncthreads();
    if (threadIdx.x == 0) {
        unsigned* bar = b.bar;
        __builtin_amdgcn_s_waitcnt(0);
        const unsigned nloc = b.st[0];
        const unsigned old = xb_add(&bar[XL_SUB(b.x)], 1u);
        const unsigned gen = old / nloc;
        if (old + 1u == (gen + 1u) * nloc) xb_add(&bar[XL_GEN(b.x)], 1u);
        else XB_SPIN(xb_ld(&bar[XL_GEN(b.x)]) == gen, bar);
        __builtin_amdgcn_fence(__ATOMIC_ACQUIRE, "agent");
        asm volatile("s_waitcnt vmcnt(0)" ::: "memory");
    }
    __syncthreads();
}

struct Order1 { pg8::StaticOrder Sa, Sk, Sv; unsigned char* ws; int na;
    DI void init(unsigned char* ws_, int G, int c) { ws = ws_; Sa.init(M, 2 * DFF, G, c); Sk.init(MM, DM, G, (c + 128) % G); Sv.init(DM, MM, G, (c + 96) % G); const int nu = (M / 256) * (2 * DFF / 256); na = c < nu ? (nu - c + G - 1) / G : 0; }
    DI bool next(int i, pg8::Unit& u) const { if (Sa.next(i, u)) return true; if (i == na) { if (Sk.next(0, u)) { u.job = 1; return true; } if (Sv.next(0, u)) { u.job = 2; return true; } } return false; }
    DI const char* baseA(const pg8::Gemm&, const pg8::Unit& u) const { return (const char*)ws + (u.job == 0 ? WS_S0 : u.job == 1 ? WS_MN : WS_WCKV + (size_t)DM * DM * 2); }
    DI const char* baseB(const pg8::Gemm&, const pg8::Unit& u) const { return (const char*)ws + (u.job == 0 ? WS_WGU : u.job == 1 ? WS_WCKV : WS_MN); }
    DI void a_ready(const pg8::Unit&) const {} DI void done(const pg8::Unit&) const {}
};
struct Epi1 { static constexpr bool PERM = true, AFTER_DRAIN = false; unsigned char* ws;
    DI void operator()(const pg8::f32x4 (&acc)[2][2][4][2], const pg8::Unit& u, int wr, int wc, int fr, int fq) const {
        if (u.job == 0) { pg8::EpiSwiGLU e{(pg8::bf16_t*)(ws + WS_S0 + SLOT), (const float*)(ws + WS_SSQ), DFF}; e(acc, u, wr, wc, fr, fq); }
        else if (u.job == 1) { pg8::EpiTileC e{(pg8::bf16_t*)(ws + WS_KX), nullptr, 1.f, 0}; e(acc, u, wr, wc, fr, fq); }
        else { pg8::EpiTileC e{(pg8::bf16_t*)(ws + WS_VXT), nullptr, 1.f, 1}; e(acc, u, wr, wc, fr, fq); }
    }
};
struct Order3 { pg8::StaticOrder Sa, Sv; unsigned char* ws;
    DI void init(unsigned char* ws_, int G, int c) { ws = ws_; Sa.init(M, 5120, G, c); Sv.init(DM, M, G, c); }
    DI bool next(int i, pg8::Unit& u) const { if (Sa.next(i, u)) return true; const int na = (1280 - Sa.c + Sa.G - 1) / Sa.G; if (Sv.next(i - na, u)) { u.job = 1; return true; } return false; }
    DI const char* baseA(const pg8::Gemm&, const pg8::Unit& u) const { return (const char*)ws + (u.job == 0 ? WS_S0 : WS_WIN + (size_t)5120 * DM * 2); }
    DI const char* baseB(const pg8::Gemm&, const pg8::Unit& u) const { return (const char*)ws + (u.job == 0 ? WS_WIN : WS_S0); }
    DI void a_ready(const pg8::Unit&) const {} DI void done(const pg8::Unit&) const {}
};
struct Epi3 { static constexpr bool PERM = true, AFTER_DRAIN = false; unsigned char* ws;
    DI void operator()(const pg8::f32x4 (&acc)[2][2][4][2], const pg8::Unit& u, int wr, int wc, int fr, int fq) const {
        const float* ssq1 = (const float*)(ws + WS_SSQ) + M;
        if (u.job == 0) { pg8::EpiMixIn e{(pg8::bf16_t*)(ws + WS_S0 + SLOT), (pg8::bf16_t*)(ws + WS_S0 + 2 * SLOT), (pg8::bf16_t*)(ws + WS_S0 + 3 * SLOT), (pg8::bf16_t*)(ws + WS_S0 + 4 * SLOT), ssq1, QSCALE_SB}; e(acc, u, wr, wc, fr, fq); }
        else { pg8::EpiVt e{(pg8::bf16_t*)(ws + WS_S0 + 5 * SLOT), ssq1}; e(acc, u, wr, wc, fr, fq); }
    }
};
struct Order5 { pg8::StaticOrder S; unsigned char* ws;
    DI void init(unsigned char* ws_, int G, int c) { ws = ws_; S.init(M, DM, G, c); }
    DI bool next(int i, pg8::Unit& u) const { if (i >= 4) return false; if (!S.next(0, u)) return false; u.job = i; return true; }
    DI const char* baseA(const pg8::Gemm&, const pg8::Unit& u) const { return (const char*)ws + (u.job == 1 ? WS_S0 + SLOT : u.job == 3 ? WS_S0 + 3 * SLOT : WS_S0); }
    DI const char* baseB(const pg8::Gemm&, const pg8::Unit& u) const { return (const char*)ws + (u.job == 0 ? WS_WIN + (size_t)6144 * DM * 2 : u.job == 1 ? WS_WCO : u.job == 2 ? WS_WIN + (size_t)7168 * DM * 2 : WS_WAO); }
    DI void a_ready(const pg8::Unit&) const {} DI void done(const pg8::Unit&) const {}
};
struct Epi5 { static constexpr bool PERM = true, AFTER_DRAIN = false; unsigned char* ws; const float* bgate;
    DI void operator()(const pg8::f32x4 (&acc)[2][2][4][2], const pg8::Unit& u, int wr, int wc, int fr, int fq) const {
        const float* ssq1 = (const float*)(ws + WS_SSQ) + M; pg8::bf16_t* S4 = (pg8::bf16_t*)(ws + WS_S0 + 4 * SLOT); pg8::bf16_t* S5 = (pg8::bf16_t*)(ws + WS_S0 + 5 * SLOT);
        if (u.job == 0) { pg8::EpiGen<1> e{S4, DM, ssq1, 1.f, bgate}; e(acc, u, wr, wc, fr, fq); }
        else if (u.job == 1) { pg8::EpiGateMul<0> e{S4, nullptr}; e(acc, u, wr, wc, fr, fq); }
        else if (u.job == 2) { pg8::EpiGen<1> e{S5, DM, ssq1, 1.f, bgate + DM}; e(acc, u, wr, wc, fr, fq); }
        else { pg8::EpiGateMul<1> e{S5, S4}; e(acc, u, wr, wc, fr, fq); }
    }
};
#define GEMM_MULTI(OrderT, EpiT, Kv, ...) do { pg8::Gemm g_{nullptr, nullptr, 0, 0, (Kv)}; OrderT S_; S_.init(ws, G, c); EpiT E_{__VA_ARGS__}; pg8::gemm_phase<EpiT, OrderT, true, true>(lds, g_, S_, E_); } while (0)

struct Params { const float* in[21]; float* out; unsigned char* ws; };
enum { I_X = 0, I_MEM, I_G_FFN1, I_W_FFN1_GU, I_W_FFN1_DOWN, I_G_MIX, I_W_IN, I_B_GATE, I_CONV_W, I_W_CONV_OUT, I_W_ATTN_OUT, I_W_O, I_G_CROSS, I_G_MEM, I_W_CQ, I_W_CKV, I_W_CO,
       I_G_FFN2, I_W_FFN2_GU, I_W_FFN2_DOWN, I_G_FINAL };

template <> DI bool cvt_decode<0>(int g, const float* const* in, unsigned char* ws, CvtItem& c) {
    if (g >= 7808) return false;
    if (g < 2816) { c.W = in[I_W_FFN1_GU]; c.WT = (bf16*)(ws + WS_WGU); c.gain = in[I_G_FFN1]; c.K = DM; c.N = 2 * DFF; c.map = 1; c.it = g; }
    else if (g < 3840) { c.W = in[I_W_CKV]; c.WT = (bf16*)(ws + WS_WCKV); c.gain = nullptr; c.K = DM; c.N = 2 * DM; c.map = 0; c.it = g - 2816; }
    else if (g < 5248) { c.W = in[I_W_FFN1_DOWN]; c.WT = (bf16*)(ws + WS_WD); c.gain = nullptr; c.K = DFF; c.N = DM; c.map = 0; c.it = g - 3840; }
    else { const int j = (g - 5248) >> 9; c.it = (g - 5248) & 511; c.K = DM; c.N = DM; c.map = 0;
        c.W = in[j == 0 ? I_W_CONV_OUT : j == 1 ? I_W_ATTN_OUT : j == 2 ? I_W_O : j == 3 ? I_W_CQ : I_W_CO];
        c.WT = (bf16*)(ws + (j == 0 ? WS_WCO : j == 1 ? WS_WAO : j == 2 ? WS_WO : j == 3 ? WS_WCQ : WS_WXO));
        c.gain = j == 3 ? in[I_G_CROSS] : nullptr; }
    return true;
}
template <> DI bool cvt_decode<1>(int g, const float* const* in, unsigned char* ws, CvtItem& c) {
    if (g >= 4224) return false;
    if (g < 2816) { c.W = in[I_W_FFN2_GU]; c.WT = (bf16*)(ws + WS_WGU); c.gain = in[I_G_FFN2]; c.K = DM; c.N = 2 * DFF; c.map = 1; c.it = g; }
    else { c.W = in[I_W_FFN2_DOWN]; c.WT = (bf16*)(ws + WS_WD); c.gain = nullptr; c.K = DFF; c.N = DM; c.map = 0; c.it = g - 2816; }
    return true;
}

#define GEMM(EpiT, Aptr, Bptr, Mv, Nv, Kv, cid, ...) do { pg8::Gemm g_{(const pg8::bf16_t*)(Aptr), (const pg8::bf16_t*)(Bptr), (Mv), (Nv), (Kv)}; pg8::StaticOrder S_; S_.init((Mv), (Nv), G, (cid)); \
        EpiT E_{__VA_ARGS__}; pg8::gemm_phase<EpiT, pg8::StaticOrder, true, true>(lds, g_, S_, E_); } while (0)

__global__ void __launch_bounds__(NTHREADS, 2) fwd_megakernel(Params P) {
    extern __shared__ __attribute__((aligned(16))) unsigned char lds_raw[];
    LAS unsigned char* lds = (LAS unsigned char*)lds_raw;
    cg::grid_group grid = cg::this_grid();
    const int tid = threadIdx.x, lane = tid & 63, wave = __builtin_amdgcn_readfirstlane(tid >> 6);
    const int G = gridDim.x, c = blockIdx.x;
    const int gw = c * NWAVES + wave, ngw = G * NWAVES;
    unsigned char* ws = P.ws;
    bf16* WGU = (bf16*)(ws + WS_WGU); bf16* WD = (bf16*)(ws + WS_WD); bf16* WIN = (bf16*)(ws + WS_WIN);
    bf16* WCO = (bf16*)(ws + WS_WCO); bf16* WAO = (bf16*)(ws + WS_WAO); bf16* WO = (bf16*)(ws + WS_WO); bf16* WCQ = (bf16*)(ws + WS_WCQ);
    bf16* WCKV = (bf16*)(ws + WS_WCKV); bf16* WXO = (bf16*)(ws + WS_WXO);
    bf16* MN = (bf16*)(ws + WS_MN); bf16* KX = (bf16*)(ws + WS_KX); bf16* VXT = (bf16*)(ws + WS_VXT);
    float* SSQ = (float*)(ws + WS_SSQ);
    float *ssq0 = SSQ, *ssq1 = SSQ + M, *ssq2 = SSQ + 2 * M, *ssq3 = SSQ + 3 * M, *ssq4 = SSQ + 4 * M;
    bf16* S0 = (bf16*)(ws + WS_S0); bf16* S1 = (bf16*)(ws + WS_S0 + SLOT); bf16* S2 = (bf16*)(ws + WS_S0 + 2 * SLOT); bf16* S3 = (bf16*)(ws + WS_S0 + 3 * SLOT);
    bf16* S4 = (bf16*)(ws + WS_S0 + 4 * SLOT); bf16* S5 = (bf16*)(ws + WS_S0 + 5 * SLOT);
    LAS float* scr = (LAS float*)(lds + wave * 16384);
    volatile LAS unsigned* bst = (volatile LAS unsigned*)(lds + LDS_RING);
    if (tid < 16) bst[tid] = 0u;
    __syncthreads();
    const XcdBarrier xbar = xcd_barrier_post((unsigned*)(ws + WS_BAR), bst);
    if (tid == 0) (void)__hip_atomic_fetch_or((unsigned*)(ws + WS_BAR) + XL_BAD + (c & 7), (1u << xb_xcc_id()) | (G != 256 ? 0x80000000u : 0u), __ATOMIC_RELAXED, __HIP_MEMORY_SCOPE_AGENT);

    {
        convert_list<0>(P.in, ws, scr, gw, ngw, lane);
        for (int m0 = 4 * gw; m0 < M; m0 += 4 * ngw) {
            f32x4 v[4][4];
#pragma unroll
            for (int q = 0; q < 4; ++q)
#pragma unroll
                for (int j = 0; j < 4; ++j) v[q][j] = __builtin_nontemporal_load((const f32x4*)(P.in[I_X] + (size_t)(m0 + q) * DM) + lane + 64 * j);
#pragma unroll
            for (int q = 0; q < 4; ++q) { unsigned long long* o8 = (unsigned long long*)(S0 + (size_t)(m0 + q) * DM) + lane; float s = 0.f;
#pragma unroll
                for (int j = 0; j < 4; ++j) { const f32x4 t = v[q][j]; s += (t.x * t.x + t.y * t.y) + (t.z * t.z + t.w * t.w);
                    o8[64 * j] = (unsigned long long)cvt_pk_bf16(t.x, t.y) | ((unsigned long long)cvt_pk_bf16(t.z, t.w) << 32); }
                s = wave_sum(s); if (lane == 0) ssq0[m0 + q] = s; }
        }
        for (int m = gw; m < MM; m += ngw) {
            const f32x4* xr = (const f32x4*)(P.in[I_MEM] + (size_t)m * DM) + lane; const f32x4* gr = (const f32x4*)P.in[I_G_MEM] + lane;
            unsigned long long* o8 = (unsigned long long*)(MN + (size_t)m * DM) + lane; f32x4 v[4]; float s = 0.f;
#pragma unroll
            for (int j = 0; j < 4; ++j) { v[j] = xr[64 * j]; s += (v[j].x * v[j].x + v[j].y * v[j].y) + (v[j].z * v[j].z + v[j].w * v[j].w); }
            const float rs = rs_of(wave_sum(s));
#pragma unroll
            for (int j = 0; j < 4; ++j) { const f32x4 g = gr[64 * j]; const f32x4 y = v[j] * rs * g;
                o8[64 * j] = (unsigned long long)cvt_pk_bf16(y.x, y.y) | ((unsigned long long)cvt_pk_bf16(y.z, y.w) << 32); }
        }
        for (int i = c * NTHREADS + tid; i < 4 * M; i += G * NTHREADS) ssq1[i] = 0.f;
    }
    if (P.ws == nullptr) grid.sync();
    xcd_barrier(xbar);
    bool fastb;
    {
        if (tid == 0) { unsigned un = 0u; bool one = true;
#pragma unroll
            for (int j = 0; j < 8; ++j) { const unsigned m = xb_ld((unsigned*)(ws + WS_BAR) + XL_BAD + j); one = one && (__builtin_popcount(m) == 1); un |= m; }
            bst[4] = (one && __builtin_popcount(un) == 8 && (un >> 16) == 0u) ? 1u : 0u; }
        __syncthreads();
        fastb = __builtin_amdgcn_readfirstlane((int)bst[4]) != 0; }
#define SEAM_LOCAL() do { if (fastb) xcd_local_barrier(xbar); else xcd_barrier(xbar); } while (0)

    GEMM_MULTI(Order1, Epi1, DM, ws);
    if (G != 256 || c >= 192) {
        const int gw2 = G == 256 ? (c - 192) * NWAVES + wave : gw, ngw2 = G == 256 ? 64 * NWAVES : ngw;
        convert_weight<2>(P.in[I_W_IN], DM, NIN, WIN, P.in[I_G_MIX], scr, gw2, ngw2, lane);
    }
    SEAM_LOCAL();

    GEMM(pg8::EpiResid, S1, WD, M, DM, DFF, c, (pg8::bf16_t*)S0, ssq1, 0.5f);
    xcd_barrier(xbar);

    GEMM_MULTI(Order3, Epi3, DM, ws);
    SEAM_LOCAL();

    {
        convert_list<1>(P.in, ws, scr, gw, ngw, lane);
        const float* cw = P.in[I_CONV_W];
        const int nbb = (G & 7) == 0 ? G >> 3 : 0;
        for (int idx = (nbb ? (c >> 3) : c) * NTHREADS + tid; idx < (nbb ? SEQ * 64 : M * 64); idx += (nbb ? nbb : G) * NTHREADS) {
            const int t = (idx >> 7) * 2 + (nbb ? (c & 7) * SEQ : 0), c8 = (idx & 127) * 8, s = t & (SEQ - 1); const size_t off = (size_t)t * 1024 + c8;
            const u32x4 z4 = {0u, 0u, 0u, 0u};
            const u32x4 r1 = *(const u32x4*)(S2 + off + 1024), r0 = *(const u32x4*)(S2 + off), rm1 = s >= 1 ? *(const u32x4*)(S2 + off - 1024) : z4, rm2 = s >= 2 ? *(const u32x4*)(S2 + off - 2048) : z4;
            const u32x4 cbr0 = *(const u32x4*)(S1 + off), cbr1 = *(const u32x4*)(S1 + off + 1024);
            f32x4 a0, a1, b0, b1, e0, e1, g0, g1, cb0, cb1, cc0, cc1;
            unpack8(r1, g0, g1); unpack8(r0, a0, a1); unpack8(rm1, b0, b1); unpack8(rm2, e0, e1); unpack8(cbr0, cb0, cb1); unpack8(cbr1, cc0, cc1);
            const f32x4 w00 = *(const f32x4*)(cw + c8), w01 = *(const f32x4*)(cw + c8 + 4), w10 = *(const f32x4*)(cw + 1024 + c8), w11 = *(const f32x4*)(cw + 1024 + c8 + 4),
                        w20 = *(const f32x4*)(cw + 2048 + c8), w21 = *(const f32x4*)(cw + 2048 + c8 + 4);
            *(u32x4*)(S1 + off) = pack8(cb0 * (w00 * e0 + w10 * b0 + w20 * a0), cb1 * (w01 * e1 + w11 * b1 + w21 * a1));
            *(u32x4*)(S1 + off + 1024) = pack8(cc0 * (w00 * b0 + w10 * a0 + w20 * g0), cc1 * (w01 * b1 + w11 * a1 + w21 * g1));
        }
        __syncthreads();
        if (nbb) { for (int j = c >> 3; j < 32; j += nbb) { const int b = c & 7, hh = j >> 2, pr = j & 3;
            sb_unit(lds, S3, S4, S5, b, hh, 7 - pr, tid, wave, lane);
            sb_unit(lds, S3, S4, S5, b, hh, pr, tid, wave, lane); } }
        else for (int u = c; u < 256; u += G) { const int bh = u >> 2, pr = u & 3;
            sb_unit(lds, S3, S4, S5, bh >> 3, bh & 7, 7 - pr, tid, wave, lane);
            sb_unit(lds, S3, S4, S5, bh >> 3, bh & 7, pr, tid, wave, lane); }
    }
    xcd_barrier(xbar);

    GEMM_MULTI(Order5, Epi5, DM, ws, P.in[I_B_GATE]);
    SEAM_LOCAL();

    GEMM(pg8::EpiResid, S5, WO, M, DM, DM, c, (pg8::bf16_t*)S0, ssq2, 1.f);
    SEAM_LOCAL();

    GEMM(pg8::EpiTileC, S0, WCQ, M, DM, DM, c, (pg8::bf16_t*)S1, ssq2, QSCALE_X, 0);
    {
#define SYNC_OWN() do { asm volatile("s_waitcnt vmcnt(0)" ::: "memory"); if (tid == 0) { __builtin_amdgcn_fence(__ATOMIC_ACQUIRE, "agent"); asm volatile("s_waitcnt vmcnt(0)" ::: "memory"); } __syncthreads(); } while (0)
        float* RS = (float*)(ws + WS_RSUM);
        pg8::StaticOrder So; So.init(M, DM, G, c);
        for (int i = 0;; ++i) { pg8::Unit u0; if (!So.next(i, u0)) break;
            const int tA = u0.pm * 4 + u0.pn, tB = (u0.pm >> 3) * 4 + u0.pn;
            SYNC_OWN();
            { pg8::Gemm g_{(const pg8::bf16_t*)S1, (const pg8::bf16_t*)KX, 0, 0, 256}; pg8::OrderOne S_{tA, tB}; pg8::EpiSoftmaxP E_{(pg8::bf16_t*)S3, RS};
              pg8::gemm_phase<pg8::EpiSoftmaxP, pg8::OrderOne, false, true>(lds, g_, S_, E_); }
            SYNC_OWN();
            { pg8::Gemm g_{(const pg8::bf16_t*)S3, (const pg8::bf16_t*)VXT, 0, 0, 256}; pg8::OrderOne S_{tA, tB}; pg8::EpiO E_{(pg8::bf16_t*)S2, RS};
              pg8::gemm_phase<pg8::EpiO, pg8::OrderOne, true, true>(lds, g_, S_, E_); }
        }
    }
    SEAM_LOCAL();

    GEMM(pg8::EpiResid, S2, WXO, M, DM, DM, c, (pg8::bf16_t*)S0, ssq3, 1.f);
    SEAM_LOCAL();

    GEMM(pg8::EpiSwiGLU, S0, WGU, M, 2 * DFF, DM, c, (pg8::bf16_t*)S1, ssq3, DFF);
    SEAM_LOCAL();

    GEMM(pg8::EpiFinal, S1, WD, M, DM, DFF, c, (const pg8::bf16_t*)S0, P.out, ssq4, 0.5f, P.in[I_G_FINAL], (unsigned*)(ws + WS_PANEL));
}

extern "C" void kernel_launch(void* const* d_in, const int* in_sizes, int n_in, void* d_out, int out_size, void* d_ws, size_t ws_size, hipStream_t stream) {
    static int grid_blocks = 0;
    if (grid_blocks == 0) {
        if (n_in != 21 || out_size != M * DM || ws_size < WS_END) { fprintf(stderr, "kernel_launch: unexpected problem (n_in %d, out %d, ws %zu)\n", n_in, out_size, ws_size); grid_blocks = -1; return; }
        int dev = 0, cus = 0, per_cu = 0;
        (void)hipGetDevice(&dev);
        (void)hipDeviceGetAttribute(&cus, hipDeviceAttributeMultiprocessorCount, dev);
        if (hipFuncSetAttribute((const void*)fwd_megakernel, hipFuncAttributeMaxDynamicSharedMemorySize, LDS_BYTES) != hipSuccess) { fprintf(stderr, "kernel_launch: hipFuncSetAttribute failed\n"); grid_blocks = -1; return; }
        if (hipOccupancyMaxActiveBlocksPerMultiprocessor(&per_cu, (const void*)fwd_megakernel, NTHREADS, LDS_BYTES) != hipSuccess || per_cu < 1) { fprintf(stderr, "kernel_launch: occupancy query failed (%d)\n", per_cu); (void)hipGetLastError(); grid_blocks = -1; return; }
        grid_blocks = cus * per_cu;
    }
    if (grid_blocks < 0) return;
    if (hipMemsetAsync((unsigned char*)d_ws + WS_BAR, 0, BAR_BYTES, stream) != hipSuccess) { fprintf(stderr, "kernel_launch: memset failed\n"); return; }
    Params p{};
    for (int i = 0; i < 21; ++i) p.in[i] = (const float*)d_in[i];
    p.out = (float*)d_out; p.ws = (unsigned char*)d_ws;
    void* args[] = {&p};
    hipError_t e = hipLaunchCooperativeKernel((const void*)fwd_megakernel, dim3(grid_blocks), dim3(NTHREADS), args, LDS_BYTES, stream);
    if (e != hipSuccess) fprintf(stderr, "cooperative launch failed: %s (grid %d)\n", hipGetErrorString(e), grid_blocks);
}
```

```cpp
#include <hip/hip_runtime.h>
#include <hip/hip_cooperative_groups.h>
#include <cstdio>
#include <cstdint>
namespace cg = cooperative_groups;
namespace pg8 {
#define PG8_LAS __attribute__((address_space(3)))
typedef unsigned short bf16_t;
typedef short bf16x8 __attribute__((ext_vector_type(8)));
typedef float f32x4 __attribute__((ext_vector_type(4)));
typedef unsigned u32x4 __attribute__((ext_vector_type(4)));
constexpr int BM = 256, BK = 64, HALF = 128, HTB = HALF * BK * 2  , STAGE_BYTES = 8 * HTB, NXCD = 8, WGM = 8;

__host__ __device__ __forceinline__ int lds_byte(int r, int c) { const int st = (r >> 4) * 2 + (c >> 5), rr = r & 15, cc = c & 31, ob = rr * 64 + cc * 2; return st * 1024 + (ob ^ (((ob >> 9) & 1) << 5)); }
__host__ __device__ __forceinline__ void stage_rc(int b, int& R, int& C) { const int st = b / 1024, sb = b % 1024, swz = sb ^ (((sb >> 9) & 1) << 5); R = (st >> 1) * 16 + swz / 64; C = (st & 1) * 32 + (swz % 64) / 2; }
__host__ __device__ __forceinline__ int perm32(int rho) { const int n = rho >> 4, i = rho & 15; return 8 * (i >> 2) + 4 * n + (i & 3); }

struct Unit { int pm, pn, job; };
struct Gemm { const bf16_t* A; const bf16_t* Bt; int M, N, K; };

struct StaticOrder {
    int nM, nN, nwg, G, c;
    __host__ __device__ void init(int M, int N, int G_, int c_) { nM = M / BM; nN = N / BM; nwg = nM * nN; G = G_; c = c_; }
    __host__ __device__ bool next(int i, Unit& u) const {
        const long L = (long)i * G + c; if (L >= nwg) return false;
        int wgid = (int)L; { const int q = nwg / NXCD, r = nwg % NXCD, xcd = wgid % NXCD, off = wgid / NXCD; wgid = (xcd < r ? xcd * (q + 1) : r * (q + 1) + (xcd - r) * q) + off; }
        const int nig = WGM * nN, gid = wgid / nig, fm = gid * WGM, gsz = (nM - fm) < WGM ? (nM - fm) : WGM;
        u.pm = fm + ((wgid % nig) % gsz); u.pn = (wgid % nig) / gsz; u.job = 0; return true;
    }
    __device__ __forceinline__ const char* baseA(const Gemm& g, const Unit&) const { return (const char*)g.A; }
    __device__ __forceinline__ const char* baseB(const Gemm& g, const Unit&) const { return (const char*)g.Bt; }
    __device__ __forceinline__ void a_ready(const Unit&) const {}
    __device__ __forceinline__ void done(const Unit&) const {}
};

typedef __bf16 bf16x2_t __attribute__((ext_vector_type(2)));
typedef float f32x2_t __attribute__((ext_vector_type(2)));
__device__ __forceinline__ unsigned cvt_pk_bf16(float lo, float hi) { f32x2_t v = {lo, hi}; bf16x2_t b = __builtin_convertvector(v, bf16x2_t); return __builtin_bit_cast(unsigned, b); }
__device__ __forceinline__ u32x4 pack8(f32x4 a, f32x4 b) { u32x4 w; w.x = cvt_pk_bf16(a[0], a[1]); w.y = cvt_pk_bf16(a[2], a[3]); w.z = cvt_pk_bf16(b[0], b[1]); w.w = cvt_pk_bf16(b[2], b[3]); return w; }
__device__ __forceinline__ float bf_lo(unsigned w) { return __builtin_bit_cast(float, w << 16); }
__device__ __forceinline__ float bf_hi(unsigned w) { return __builtin_bit_cast(float, w & 0xffff0000u); }
__device__ __forceinline__ void unpack8(u32x4 w, f32x4& a, f32x4& b) { a = (f32x4){bf_lo(w.x), bf_hi(w.x), bf_lo(w.y), bf_hi(w.y)}; b = (f32x4){bf_lo(w.z), bf_hi(w.z), bf_lo(w.w), bf_hi(w.w)}; }
constexpr float RMS_EPS_F = 1e-6f;
__device__ __forceinline__ float rs_of(float ssq) { return __builtin_amdgcn_rsqf(ssq * (1.f / 1024.f) + RMS_EPS_F); }
__device__ __forceinline__ float sigmoid_f(float v) { return __builtin_amdgcn_rcpf(1.f + __builtin_amdgcn_exp2f(-1.4426950408889634f * v)); }

struct EpiSwiGLU {
    static constexpr bool PERM = true, AFTER_DRAIN = false;
    bf16_t* O; const float* ssq; int ldo;
    __device__ __forceinline__ void operator()(const f32x4 (&acc)[2][2][4][2], const Unit& u, int wr, int wc, int fr, int fq) const {
        const int row0 = u.pm * BM + wr * 64 + fr, col0 = u.pn * HALF + wc * 32 + 8 * fq;
        float sv[2][4];
#pragma unroll
        for (int ai = 0; ai < 2; ++ai)
#pragma unroll
            for (int m = 0; m < 4; ++m) sv[ai][m] = ssq[row0 + ai * HALF + m * 16];
#pragma unroll
        for (int ai = 0; ai < 2; ++ai)
#pragma unroll
            for (int m = 0; m < 4; ++m) { const int row = row0 + ai * HALF + m * 16; const float r = rs_of(sv[ai][m]), k1 = -1.4426950408889634f * r, r2 = r * r;
                f32x4 o[2];
#pragma unroll
                for (int n = 0; n < 2; ++n) { const f32x4 ag = acc[ai][0][m][n], gu = ag * acc[ai][1][m][n];
#pragma unroll
                    for (int e = 0; e < 4; ++e) o[n][e] = gu[e] * (r2 * __builtin_amdgcn_rcpf(1.f + __builtin_amdgcn_exp2f(ag[e] * k1))); }
                *(u32x4*)(O + (size_t)row * ldo + col0) = pack8(o[0], o[1]); }
    }
};

struct EpiResid {
    static constexpr bool PERM = true, AFTER_DRAIN = false;
    bf16_t* HB; float* ssq; float alpha;
    __device__ __forceinline__ void operator()(const f32x4 (&acc)[2][2][4][2], const Unit& u, int wr, int wc, int fr, int fq) const {
        const int row0 = u.pm * BM + wr * 64 + fr, col0 = u.pn * BM + wc * 32 + 8 * fq;
#pragma unroll
        for (int ai = 0; ai < 2; ++ai)
#pragma unroll
            for (int m = 0; m < 4; ++m) { const int row = row0 + ai * HALF + m * 16; float ss = 0.f;
#pragma unroll
                for (int bj = 0; bj < 2; ++bj) { const size_t off = (size_t)row * 1024 + col0 + bj * HALF;
                    f32x4 a, b; unpack8(*(const u32x4*)(HB + off), a, b);
                    a = a + acc[ai][bj][m][0] * alpha; b = b + acc[ai][bj][m][1] * alpha;
                    *(u32x4*)(HB + off) = pack8(a, b);
                    ss += (a[0] * a[0] + a[1] * a[1]) + (a[2] * a[2] + a[3] * a[3]) + (b[0] * b[0] + b[1] * b[1]) + (b[2] * b[2] + b[3] * b[3]); }
                ss += __shfl_xor(ss, 16); ss += __shfl_xor(ss, 32);
                if (fq == 0) unsafeAtomicAdd(ssq + row, ss); }
    }
};

struct EpiMixIn {
    static constexpr bool PERM = true, AFTER_DRAIN = false;
    bf16_t *CB, *CCX, *Q, *Kb; const float* ssq; float qscale;
    __device__ __forceinline__ void operator()(const f32x4 (&acc)[2][2][4][2], const Unit& u, int wr, int wc, int fr, int fq) const {
        const int row0 = u.pm * BM + wr * 64 + fr, pn = u.pn;
        float sv[2][4];
#pragma unroll
        for (int ai = 0; ai < 2; ++ai)
#pragma unroll
            for (int m = 0; m < 4; ++m) sv[ai][m] = ssq[row0 + ai * HALF + m * 16];
        if (pn >= 4 && pn < 12) {
            const int col0 = (pn - 4) * HALF + wc * 32 + 8 * fq;
#pragma unroll
            for (int ai = 0; ai < 2; ++ai)
#pragma unroll
                for (int m = 0; m < 4; ++m) { const int row = row0 + ai * HALF + m * 16; const float r = rs_of(sv[ai][m]), r2 = r * r;
                    *(u32x4*)(CCX + (size_t)row * 1024 + col0) = pack8(acc[ai][0][m][0] * acc[ai][1][m][0] * r2, acc[ai][0][m][1] * acc[ai][1][m][1] * r2); }
        } else {
            bf16_t* base; int colt; float sc = 1.f;
            if (pn < 4) { base = CB; colt = pn * BM; } else if (pn < 16) { base = Q; colt = (pn - 12) * BM; sc = qscale; } else { base = Kb; colt = (pn - 16) * BM; }
            const int col0 = colt + wc * 32 + 8 * fq;
#pragma unroll
            for (int ai = 0; ai < 2; ++ai)
#pragma unroll
                for (int m = 0; m < 4; ++m) { const int row = row0 + ai * HALF + m * 16; const float r = rs_of(sv[ai][m]) * sc;
#pragma unroll
                    for (int bj = 0; bj < 2; ++bj) *(u32x4*)(base + (size_t)row * 1024 + col0 + bj * HALF) = pack8(acc[ai][bj][m][0] * r, acc[ai][bj][m][1] * r); }
        }
    }
};

struct EpiVt {
    static constexpr bool PERM = true, AFTER_DRAIN = false;
    bf16_t* O; const float* ssq;
    __device__ __forceinline__ void operator()(const f32x4 (&acc)[2][2][4][2], const Unit& u, int wr, int wc, int fr, int fq) const {
        const int ch0 = u.pm * BM + wr * 64 + fr, tok0 = u.pn * BM + wc * 32 + 8 * fq;
        f32x4 sc[2][2];
#pragma unroll
        for (int bj = 0; bj < 2; ++bj)
#pragma unroll
            for (int n = 0; n < 2; ++n) {
                if (ssq) { const f32x4 s = *(const f32x4*)(ssq + tok0 + bj * HALF + 4 * n); sc[bj][n] = (f32x4){rs_of(s[0]), rs_of(s[1]), rs_of(s[2]), rs_of(s[3])}; }
                else sc[bj][n] = (f32x4){1.f, 1.f, 1.f, 1.f}; }
#pragma unroll
        for (int ai = 0; ai < 2; ++ai)
#pragma unroll
            for (int m = 0; m < 4; ++m) { const int ch = ch0 + ai * HALF + m * 16;
#pragma unroll
                for (int bj = 0; bj < 2; ++bj) { const int tok = tok0 + bj * HALF;
                    *(u32x4*)(O + ((size_t)(tok >> 11) * 1024 + ch) * 2048 + (tok & 2047)) = pack8(acc[ai][bj][m][0] * sc[bj][0], acc[ai][bj][m][1] * sc[bj][1]); } }
    }
};

template <int SIG> struct EpiGen {
    static constexpr bool PERM = true, AFTER_DRAIN = false;
    bf16_t* O; int ldc; const float* ssq; float sc; const float* bias;
    __device__ __forceinline__ void operator()(const f32x4 (&acc)[2][2][4][2], const Unit& u, int wr, int wc, int fr, int fq) const {
        const int row0 = u.pm * BM + wr * 64 + fr, col0 = u.pn * BM + wc * 32 + 8 * fq;
        f32x4 bv[2][2];
#pragma unroll
        for (int bj = 0; bj < 2; ++bj)
#pragma unroll
            for (int n = 0; n < 2; ++n) bv[bj][n] = bias ? *(const f32x4*)(bias + col0 + bj * HALF + 4 * n) : (f32x4){0.f, 0.f, 0.f, 0.f};
        float sv[2][4];
#pragma unroll
        for (int ai = 0; ai < 2; ++ai)
#pragma unroll
            for (int m = 0; m < 4; ++m) sv[ai][m] = ssq ? ssq[row0 + ai * HALF + m * 16] : 0.f;
#pragma unroll
        for (int ai = 0; ai < 2; ++ai)
#pragma unroll
            for (int m = 0; m < 4; ++m) { const int row = row0 + ai * HALF + m * 16; const float r = (ssq ? rs_of(sv[ai][m]) : 1.f) * sc;
#pragma unroll
                for (int bj = 0; bj < 2; ++bj) { f32x4 v0 = acc[ai][bj][m][0] * r + bv[bj][0], v1 = acc[ai][bj][m][1] * r + bv[bj][1];
                    if (SIG) {
#pragma unroll
                        for (int e = 0; e < 4; ++e) { v0[e] = sigmoid_f(v0[e]); v1[e] = sigmoid_f(v1[e]); } }
                    *(u32x4*)(O + (size_t)row * ldc + col0 + bj * HALF) = pack8(v0, v1); } }
    }
};

template <int ADD> struct EpiGateMul {
    static constexpr bool PERM = true, AFTER_DRAIN = false;
    bf16_t* G; const bf16_t* T;
    __device__ __forceinline__ void operator()(const f32x4 (&acc)[2][2][4][2], const Unit& u, int wr, int wc, int fr, int fq) const {
        const int row0 = u.pm * BM + wr * 64 + fr, col0 = u.pn * BM + wc * 32 + 8 * fq;
#pragma unroll
        for (int ai = 0; ai < 2; ++ai)
#pragma unroll
            for (int m = 0; m < 4; ++m) { const int row = row0 + ai * HALF + m * 16;
#pragma unroll
                for (int bj = 0; bj < 2; ++bj) { const size_t off = (size_t)row * 1024 + col0 + bj * HALF;
                    f32x4 g0, g1; unpack8(*(const u32x4*)(G + off), g0, g1);
                    f32x4 v0 = g0 * acc[ai][bj][m][0], v1 = g1 * acc[ai][bj][m][1];
                    if (ADD) { f32x4 t0, t1; unpack8(*(const u32x4*)(T + off), t0, t1); v0 = v0 + t0; v1 = v1 + t1; }
                    *(u32x4*)(G + off) = pack8(v0, v1); } }
    }
};

struct EpiFinal {
    static constexpr bool PERM = true, AFTER_DRAIN = false;
    const bf16_t* Hin; float* Out; float* ssq; float alpha; const float* gain; unsigned* cnt;
    __device__ __forceinline__ void operator()(const f32x4 (&acc_)[2][2][4][2], const Unit& u, int wr, int wc, int fr, int fq) const {
        f32x4 (&acc)[2][2][4][2] = const_cast<f32x4 (&)[2][2][4][2]>(acc_);
        const int row0 = u.pm * BM + wr * 64 + fr, col0 = u.pn * BM + wc * 32 + 8 * fq;
#pragma unroll
        for (int ai = 0; ai < 2; ++ai)
#pragma unroll
            for (int m = 0; m < 4; ++m) { const int row = row0 + ai * HALF + m * 16; float ss = 0.f;
#pragma unroll
                for (int bj = 0; bj < 2; ++bj) { const size_t off = (size_t)row * 1024 + col0 + bj * HALF;
                    f32x4 a, b; unpack8(*(const u32x4*)(Hin + off), a, b);
                    a = a + acc[ai][bj][m][0] * alpha; b = b + acc[ai][bj][m][1] * alpha;
                    acc[ai][bj][m][0] = a; acc[ai][bj][m][1] = b;
                    ss += (a[0] * a[0] + a[1] * a[1]) + (a[2] * a[2] + a[3] * a[3]) + (b[0] * b[0] + b[1] * b[1]) + (b[2] * b[2] + b[3] * b[3]); }
                ss += __shfl_xor(ss, 16); ss += __shfl_xor(ss, 32);
                if (fq == 0) unsafeAtomicAdd(ssq + row, ss); }
        asm volatile("s_waitcnt vmcnt(0)" ::: "memory");
        unsigned* pc = cnt + u.pm * 32;
        unsigned* pf = pc + 2048;
        if (fr == 0 && fq == 0) { if (__hip_atomic_fetch_add(pc, 1u, __ATOMIC_RELAXED, __HIP_MEMORY_SCOPE_AGENT) == 31u) __hip_atomic_store(pf, 1u, __ATOMIC_RELAXED, __HIP_MEMORY_SCOPE_AGENT); }
        { unsigned sp = 0; while (__hip_atomic_load(pf, __ATOMIC_RELAXED, __HIP_MEMORY_SCOPE_AGENT) == 0u && ++sp < (1u << 22)) __builtin_amdgcn_s_sleep(4); }
        f32x4 gv[2][2];
#pragma unroll
        for (int bj = 0; bj < 2; ++bj)
#pragma unroll
            for (int n = 0; n < 2; ++n) gv[bj][n] = *(const f32x4*)(gain + col0 + bj * HALF + 4 * n);
#pragma unroll
        for (int ai = 0; ai < 2; ++ai)
#pragma unroll
            for (int m = 0; m < 4; ++m) { const int row = row0 + ai * HALF + m * 16;
                const float r = rs_of(__hip_atomic_load(ssq + row, __ATOMIC_RELAXED, __HIP_MEMORY_SCOPE_AGENT));
#pragma unroll
                for (int bj = 0; bj < 2; ++bj) { const size_t off = (size_t)row * 1024 + col0 + bj * HALF;
                    __builtin_nontemporal_store(acc[ai][bj][m][0] * r * gv[bj][0], (f32x4*)(Out + off)); __builtin_nontemporal_store(acc[ai][bj][m][1] * r * gv[bj][1], (f32x4*)(Out + off + 4)); } }
    }
};

struct EpiTileC {
    static constexpr bool PERM = true, AFTER_DRAIN = false;
    bf16_t* O; const float* ssq; float sc; int swap;
    __device__ __forceinline__ void operator()(const f32x4 (&acc)[2][2][4][2], const Unit& u, int wr, int wc, int fr, int fq) const {
        const int tile = swap ? (u.pn * 4 + u.pm) : (u.pm * 4 + u.pn), rl0 = wr * 64 + fr, cl0 = wc * 32 + 8 * fq;
        bf16_t* base = O + (size_t)tile * 65536;
        float sv[2][4];
#pragma unroll
        for (int ai = 0; ai < 2; ++ai)
#pragma unroll
            for (int m = 0; m < 4; ++m) sv[ai][m] = ssq ? ssq[u.pm * BM + rl0 + ai * HALF + m * 16] : 0.f;
#pragma unroll
        for (int ai = 0; ai < 2; ++ai)
#pragma unroll
            for (int m = 0; m < 4; ++m) { const int rl = rl0 + ai * HALF + m * 16; const float r = (ssq ? rs_of(sv[ai][m]) : 1.f) * sc;
#pragma unroll
                for (int bj = 0; bj < 2; ++bj) *(u32x4*)(base + rl * 256 + cl0 + bj * HALF) = pack8(acc[ai][bj][m][0] * r, acc[ai][bj][m][1] * r); }
    }
};
struct EpiSoftmaxP {
    static constexpr bool PERM = true, AFTER_DRAIN = true;
    bf16_t* Pm; float* rsum;
    __device__ __forceinline__ void fused(const f32x4 (&acc)[2][2][4][2], const Unit& u, int wr, int wc, int fr, int fq, PG8_LAS unsigned char* lds, int, int) const {
        PG8_LAS float* red = (PG8_LAS float*)lds;
        const int rl0 = wr * 64 + fr, cl0 = wc * 32 + 8 * fq;
        float mx[2][4];
#pragma unroll
        for (int ai = 0; ai < 2; ++ai)
#pragma unroll
            for (int m = 0; m < 4; ++m) { float v = acc[ai][0][m][0][0];
#pragma unroll
                for (int bj = 0; bj < 2; ++bj)
#pragma unroll
                    for (int n = 0; n < 2; ++n)
#pragma unroll
                        for (int e = 0; e < 4; ++e) v = __builtin_fmaxf(v, acc[ai][bj][m][n][e]);
                v = __builtin_fmaxf(v, __shfl_xor(v, 16)); v = __builtin_fmaxf(v, __shfl_xor(v, 32));
                if (fq == 0) red[(rl0 + ai * HALF + m * 16) * 4 + wc] = v; }
        __syncthreads();
#pragma unroll
        for (int ai = 0; ai < 2; ++ai)
#pragma unroll
            for (int m = 0; m < 4; ++m) { const f32x4 t = *(const PG8_LAS f32x4*)(red + (rl0 + ai * HALF + m * 16) * 4); mx[ai][m] = __builtin_fmaxf(__builtin_fmaxf(t[0], t[1]), __builtin_fmaxf(t[2], t[3])); }
        __syncthreads();
        bf16_t* base = Pm + (size_t)u.pm * 65536;
#pragma unroll
        for (int ai = 0; ai < 2; ++ai)
#pragma unroll
            for (int m = 0; m < 4; ++m) { const int rl = rl0 + ai * HALF + m * 16; float sm = 0.f;
#pragma unroll
                for (int bj = 0; bj < 2; ++bj) { f32x4 p0, p1;
#pragma unroll
                    for (int e = 0; e < 4; ++e) { p0[e] = __builtin_amdgcn_exp2f(acc[ai][bj][m][0][e] - mx[ai][m]); p1[e] = __builtin_amdgcn_exp2f(acc[ai][bj][m][1][e] - mx[ai][m]); }
                    sm += (p0[0] + p0[1]) + (p0[2] + p0[3]) + (p1[0] + p1[1]) + (p1[2] + p1[3]);
                    *(u32x4*)(base + rl * 256 + cl0 + bj * HALF) = pack8(p0, p1); }
                sm += __shfl_xor(sm, 16); sm += __shfl_xor(sm, 32);
                if (fq == 0) red[rl * 4 + wc] = sm; }
        __syncthreads();
        if (wc == 0 && fq == 0) {
#pragma unroll
            for (int ai = 0; ai < 2; ++ai)
#pragma unroll
                for (int m = 0; m < 4; ++m) { const int rl = rl0 + ai * HALF + m * 16; const f32x4 t = *(const PG8_LAS f32x4*)(red + rl * 4); rsum[u.pm * 256 + rl] = (t[0] + t[1]) + (t[2] + t[3]); }
        }
    }
};
struct EpiO {
    static constexpr bool PERM = true, AFTER_DRAIN = false;
    bf16_t* OX; const float* rsum;
    __device__ __forceinline__ void operator()(const f32x4 (&acc)[2][2][4][2], const Unit& u, int wr, int wc, int fr, int fq) const {
        const int rl0 = wr * 64 + fr, cl0 = wc * 32 + 8 * fq, hx = u.pm & 3, row0 = (u.pm >> 2) * BM;
        float sv[2][4];
#pragma unroll
        for (int ai = 0; ai < 2; ++ai)
#pragma unroll
            for (int m = 0; m < 4; ++m) sv[ai][m] = rsum[u.pm * 256 + rl0 + ai * HALF + m * 16];
#pragma unroll
        for (int ai = 0; ai < 2; ++ai)
#pragma unroll
            for (int m = 0; m < 4; ++m) { const int rl = rl0 + ai * HALF + m * 16; const float r = __builtin_amdgcn_rcpf(sv[ai][m]);
#pragma unroll
                for (int bj = 0; bj < 2; ++bj) *(u32x4*)(OX + (size_t)(row0 + rl) * 1024 + hx * 256 + cl0 + bj * HALF) = pack8(acc[ai][bj][m][0] * r, acc[ai][bj][m][1] * r); }
    }
};
struct OrderOne {
    int tA, tB;
    __device__ __forceinline__ bool next(int i, Unit& u) const { if (i > 0) return false; u.pm = tA; u.pn = tB; u.job = 0; return true; }
    __device__ __forceinline__ const char* baseA(const Gemm& g, const Unit&) const { return (const char*)g.A; }
    __device__ __forceinline__ const char* baseB(const Gemm& g, const Unit&) const { return (const char*)g.Bt; }
    __device__ __forceinline__ void a_ready(const Unit&) const {}
    __device__ __forceinline__ void done(const Unit&) const {}
};

template <class Epi, class Sched, bool ALIGN_EPI = false, bool SP2 = false>
__device__ __forceinline__ void gemm_phase(PG8_LAS unsigned char* lds, const Gemm g, const Sched& S, const Epi& E) {
    int tid_o = threadIdx.x; asm volatile("" : "+v"(tid_o));
    const int tid = tid_o, wid = __builtin_amdgcn_readfirstlane(tid >> 6), lane = tid & 63, wr = wid >> 2, wc = wid & 3, fr = lane & 15, fq = lane >> 4;
    const int K = g.K, nt = K / BK;
    unsigned voffA[2], voffB[2];
#pragma unroll
    for (int i = 0; i < 2; ++i) { int R, C; stage_rc(tid * 16 + i * 8192, R, C); const int Rb = Epi::PERM ? ((R & ~31) + perm32(R & 31)) : R;
        voffA[i] = (unsigned)(R * K + C) * 2u; voffB[i] = (unsigned)(Rb * K + C) * 2u; }
    const size_t kstep = (size_t)(BK * 2);
    const size_t hstep = (size_t)HALF * K * 2;
    const size_t tstep = 2 * hstep;
    const unsigned ldsw = (unsigned)wid * 1024u;
    const int aoff = lds_byte(wr * 64 + fr, fq * 8), boff = lds_byte(wc * 32 + fr, fq * 8);
#define PG8_SA(b, h) (((b) * 2 + (h)) * HTB)
#define PG8_SB(b, h) ((4 + (b) * 2 + (h)) * HTB)
#define PG8_STAGE(bufoff, gbase, voff) do { _Pragma("unroll") for (int _i = 0; _i < 2; ++_i) \
        __builtin_amdgcn_global_load_lds((const unsigned*)((const char*)(gbase) + (voff)[_i]), (PG8_LAS unsigned*)(lds + (bufoff) + ldsw + _i * 8192), 16, 0, 0); } while (0)
#define PG8_LDA(dst, b, h) do { _Pragma("unroll") for (int m = 0; m < 4; ++m) _Pragma("unroll") for (int k = 0; k < 2; ++k) dst[m][k] = *(const PG8_LAS bf16x8*)(lds + PG8_SA(b, h) + aoff + m * 2048 + k * 1024); } while (0)
#define PG8_LDB(dst, b, h) do { _Pragma("unroll") for (int n = 0; n < 2; ++n) _Pragma("unroll") for (int k = 0; k < 2; ++k) dst[n][k] = *(const PG8_LAS bf16x8*)(lds + PG8_SB(b, h) + boff + n * 2048 + k * 1024); } while (0)
#define PG8_MMA(ai, bj, At, Bt) do { __builtin_amdgcn_sched_barrier(0); _Pragma("unroll") for (int m = 0; m < 4; ++m) _Pragma("unroll") for (int n = 0; n < 2; ++n) _Pragma("unroll") for (int k = 0; k < 2; ++k) \
        acc[ai][bj][m][n] = __builtin_amdgcn_mfma_f32_16x16x32_bf16(Bt[n][k], At[m][k], acc[ai][bj][m][n], 0, 0, 0); __builtin_amdgcn_sched_barrier(0); } while (0)
#define PG8_WAIT_V(n) asm volatile("s_waitcnt vmcnt(" #n ")" ::: "memory")
#define PG8_WAIT_L(n) asm volatile("s_waitcnt lgkmcnt(" #n ")" ::: "memory")
#define PG8_BAR __builtin_amdgcn_s_barrier()
#define PG8_SCHED __builtin_amdgcn_sched_barrier(0)
    Unit cur, nxt; int ui = 0;
    if (!S.next(0, cur)) return;
    f32x4 acc[2][2][4][2];
#pragma unroll
    for (int a = 0; a < 2; ++a)
#pragma unroll
        for (int b = 0; b < 2; ++b)
#pragma unroll
            for (int m = 0; m < 4; ++m)
#pragma unroll
                for (int n = 0; n < 2; ++n) acc[a][b][m][n] = (f32x4){0.f, 0.f, 0.f, 0.f};
    bf16x8 At[4][2], B0[2][2], B1[2][2];
    const char* cA = S.baseA(g, cur) + (size_t)cur.pm * tstep; const char* cB = S.baseB(g, cur) + (size_t)cur.pn * tstep;
    S.a_ready(cur);
    if constexpr (SP2) {
        PG8_STAGE(PG8_SB(0, 0), cB, voffB); PG8_STAGE(PG8_SB(0, 1), cB + hstep, voffB); PG8_STAGE(PG8_SA(0, 0), cA, voffA); PG8_STAGE(PG8_SA(0, 1), cA + hstep, voffA);
        if (wr == 1) PG8_BAR;
        PG8_WAIT_V(2); PG8_BAR;
        PG8_STAGE(PG8_SB(1, 0), cB + kstep, voffB); PG8_STAGE(PG8_SA(1, 0), cA + kstep, voffA); PG8_STAGE(PG8_SB(1, 1), cB + hstep + kstep, voffB);
        PG8_WAIT_V(6); PG8_BAR;
    } else {
        PG8_STAGE(PG8_SB(0, 0), cB, voffB); PG8_STAGE(PG8_SA(0, 0), cA, voffA); PG8_STAGE(PG8_SB(0, 1), cB + hstep, voffB); PG8_STAGE(PG8_SA(0, 1), cA + hstep, voffA);
        if (wr == 1) PG8_BAR;
        PG8_WAIT_V(4); PG8_BAR;
        PG8_STAGE(PG8_SB(1, 0), cB + kstep, voffB); PG8_STAGE(PG8_SA(1, 0), cA + kstep, voffA); PG8_STAGE(PG8_SB(1, 1), cB + hstep + kstep, voffB);
        PG8_WAIT_V(6); PG8_BAR;
    }
    for (;;) {
        const bool has_next = S.next(ui + 1, nxt);
        const char* nA = has_next ? S.baseA(g, nxt) + (size_t)nxt.pm * tstep : cA; const char* nB = has_next ? S.baseB(g, nxt) + (size_t)nxt.pn * tstep : cB;
        for (int t = 0; t < nt; t += 2) {
            const bool last = (t == nt - 2);
            const char* a1 = cA + (size_t)(t + 1) * kstep;
            const char* a2 = last ? nA : cA + (size_t)(t + 2) * kstep; const char* b2 = last ? nB : cB + (size_t)(t + 2) * kstep;
            const char* a3 = a2 + kstep; const char* b3 = b2 + kstep;
            if (last && has_next) S.a_ready(nxt);
            if constexpr (SP2) {
            PG8_LDB(B0, 0, 0); PG8_LDB(B1, 0, 1); PG8_SCHED; PG8_LDA(At, 0, 0); PG8_STAGE(PG8_SA(1, 1), a1 + hstep, voffA);
            PG8_WAIT_V(8); PG8_WAIT_L(0); PG8_BAR; PG8_MMA(0, 0, At, B0); PG8_MMA(0, 1, At, B1); PG8_BAR; PG8_SCHED;
            PG8_LDA(At, 0, 1); PG8_STAGE(PG8_SB(0, 0), b2, voffB); PG8_STAGE(PG8_SB(0, 1), b2 + hstep, voffB); PG8_STAGE(PG8_SA(0, 0), a2, voffA);
            PG8_WAIT_V(8); PG8_WAIT_L(0); PG8_BAR; PG8_MMA(1, 0, At, B0); PG8_MMA(1, 1, At, B1); PG8_BAR; PG8_SCHED;
            PG8_LDB(B0, 1, 0); PG8_LDB(B1, 1, 1); PG8_SCHED; PG8_LDA(At, 1, 0); PG8_STAGE(PG8_SA(0, 1), a2 + hstep, voffA);
            PG8_WAIT_V(8); PG8_WAIT_L(0); PG8_BAR; PG8_MMA(0, 0, At, B0); PG8_MMA(0, 1, At, B1); PG8_BAR; PG8_SCHED;
            PG8_LDA(At, 1, 1); PG8_STAGE(PG8_SB(1, 0), b3, voffB); PG8_STAGE(PG8_SB(1, 1), b3 + hstep, voffB); PG8_STAGE(PG8_SA(1, 0), a3, voffA);
            PG8_WAIT_V(8); PG8_WAIT_L(0); PG8_BAR; PG8_MMA(1, 0, At, B0); PG8_MMA(1, 1, At, B1); PG8_BAR; PG8_SCHED;
            } else {
            PG8_LDB(B0, 0, 0); PG8_SCHED; PG8_LDA(At, 0, 0); PG8_STAGE(PG8_SA(1, 1), a1 + hstep, voffA);
            PG8_WAIT_L(8); PG8_BAR; PG8_WAIT_L(0); PG8_MMA(0, 0, At, B0); PG8_BAR; PG8_SCHED;
            PG8_LDB(B1, 0, 1); PG8_STAGE(PG8_SB(0, 0), b2, voffB);
            PG8_BAR; PG8_WAIT_L(0); PG8_MMA(0, 1, At, B1); PG8_BAR;
            PG8_LDA(At, 0, 1); PG8_STAGE(PG8_SA(0, 0), a2, voffA);
            PG8_BAR; PG8_WAIT_L(0); PG8_MMA(1, 0, At, B0); PG8_BAR; PG8_SCHED;
            PG8_STAGE(PG8_SB(0, 1), b2 + hstep, voffB);
            PG8_WAIT_V(6); PG8_BAR; PG8_MMA(1, 1, At, B1); PG8_BAR;
            PG8_LDB(B0, 1, 0); PG8_SCHED; PG8_LDA(At, 1, 0); PG8_STAGE(PG8_SA(0, 1), a2 + hstep, voffA);
            PG8_WAIT_L(8); PG8_BAR; PG8_WAIT_L(0); PG8_MMA(0, 0, At, B0); PG8_BAR; PG8_SCHED;
            PG8_LDB(B1, 1, 1); PG8_STAGE(PG8_SB(1, 0), b3, voffB);
            PG8_BAR; PG8_WAIT_L(0); PG8_MMA(0, 1, At, B1); PG8_BAR;
            PG8_LDA(At, 1, 1); PG8_STAGE(PG8_SA(1, 0), a3, voffA);
            PG8_BAR; PG8_WAIT_L(0); PG8_MMA(1, 0, At, B0); PG8_BAR; PG8_SCHED;
            PG8_STAGE(PG8_SB(1, 1), b3 + hstep, voffB);
            PG8_WAIT_V(6); PG8_BAR; PG8_MMA(1, 1, At, B1); PG8_BAR;
            }
        }
        if constexpr (ALIGN_EPI) { if (wr == 0) PG8_BAR; }
        if constexpr (!Epi::AFTER_DRAIN) { E(acc, cur, wr, wc, fr, fq); S.done(cur); }
        if (!has_next) break;
#pragma unroll
        for (int a = 0; a < 2; ++a)
#pragma unroll
            for (int b = 0; b < 2; ++b)
#pragma unroll
                for (int m = 0; m < 4; ++m)
#pragma unroll
                    for (int n = 0; n < 2; ++n) acc[a][b][m][n] = (f32x4){0.f, 0.f, 0.f, 0.f};
        cur = nxt; cA = nA; cB = nB; ++ui;
        if constexpr (ALIGN_EPI) { if (wr == 1) PG8_BAR; }
    }
    PG8_WAIT_V(0);
    if constexpr (!ALIGN_EPI) { if (wr == 0) PG8_BAR; }
    PG8_BAR;
    if constexpr (Epi::AFTER_DRAIN) { E.fused(acc, cur, wr, wc, fr, fq, lds, wid, lane); S.done(cur); }
#undef PG8_SA
#undef PG8_SB
#undef PG8_STAGE
#undef PG8_LDA
#undef PG8_LDB
#undef PG8_MMA
#undef PG8_WAIT_V
#undef PG8_WAIT_L
#undef PG8_BAR
#undef PG8_SCHED
}
}

constexpr int NWAVES = 8, NTHREADS = NWAVES * 64;
constexpr int BATCH = 8, SEQ = 2048, DM = 1024, M = BATCH * SEQ, DFF = 2816, MEMLEN = 256, MM = BATCH * MEMLEN;
constexpr int NIN = 8192;
constexpr float QSCALE_SB = 0.08838834764831845f * 1.4426950408889634f;
constexpr float QSCALE_X = 0.0625f * 1.4426950408889634f;

constexpr size_t KiB = 1024, MiB = 1u << 20;
constexpr size_t WS_WGU = 0;
constexpr size_t WS_WD = 11 * MiB;
constexpr size_t WS_WIN = WS_WD + 5632 * KiB;
constexpr size_t WS_WCO = WS_WIN + 16 * MiB;
constexpr size_t WS_WAO = WS_WCO + 2 * MiB;
constexpr size_t WS_WO = WS_WAO + 2 * MiB;
constexpr size_t WS_WCQ = WS_WO + 2 * MiB;
constexpr size_t WS_WCKV = WS_WCQ + 2 * MiB;
constexpr size_t WS_WXO = WS_WCKV + 4 * MiB;
constexpr size_t WS_MN = WS_WXO + 2 * MiB;
constexpr size_t WS_KX = WS_MN + 4 * MiB;
constexpr size_t WS_VXT = WS_KX + 4 * MiB;
constexpr size_t WS_SSQ = WS_VXT + 4 * MiB;
constexpr size_t WS_S0 = WS_SSQ + 512 * KiB;
constexpr size_t SLOT = 32 * MiB;
constexpr size_t WS_END = WS_S0 + 6 * SLOT;
static_assert(WS_END + 32768 <= 256 * MiB, "d_ws map");

constexpr int LDS_RING = 139264, LDS_BYTES = LDS_RING + 64;
constexpr size_t WS_BAR = WS_END, BAR_BYTES = 65536;
constexpr size_t WS_RSUM = WS_BAR + BAR_BYTES;
static_assert(WS_RSUM + 262144 <= 256 * MiB, "d_ws map");
constexpr size_t WS_PANEL = WS_BAR + 32768;

#define GAS __attribute__((address_space(1)))
#define LAS __attribute__((address_space(3)))
#define DI __device__ __forceinline__
typedef unsigned short bf16;
typedef unsigned u32x4 __attribute__((ext_vector_type(4)));
typedef unsigned u32x2 __attribute__((ext_vector_type(2)));
typedef float f32x4 __attribute__((ext_vector_type(4)));
typedef float f32x16 __attribute__((ext_vector_type(16)));
typedef short bf16x8 __attribute__((ext_vector_type(8)));
#define LDS_WAIT() asm volatile("s_waitcnt lgkmcnt(0)" ::: "memory")
#define MFMA32(a, b, c) __builtin_amdgcn_mfma_f32_32x32x16_bf16((a), (b), (c), 0, 0, 0)
using pg8::cvt_pk_bf16; using pg8::pack8; using pg8::unpack8; using pg8::rs_of;

DI float wave_sum(float v) {
#pragma unroll
    for (int o = 1; o < 64; o <<= 1) v += __shfl_xor(v, o);
    return v;
}

DI void tr_load(float (&wv)[32], const float* W, int N, int k0, int n0, int lane) {
    const float* wp = W + (size_t)(k0 + (lane >> 5)) * N + n0 + (lane & 31);
#pragma unroll
    for (int i = 0; i < 32; ++i) wv[i] = __builtin_nontemporal_load(wp + (size_t)(2 * i) * N);
}
DI void tr_finish(float (&wv)[32], int K, bf16* WT, int dst_row0, const float* gain, LAS float* scr, int k0, int lane) {
    if (gain) {
#pragma unroll
        for (int i = 0; i < 32; ++i) wv[i] *= gain[k0 + 2 * i + (lane >> 5)];
    }
#pragma unroll
    for (int i = 0; i < 32; ++i) scr[(2 * i + (lane >> 5)) * 33 + (lane & 31)] = wv[i];
    LDS_WAIT(); asm volatile("" ::: "memory");
    const int c = lane & 7;
#pragma unroll
    for (int j = 0; j < 4; ++j) { const int n = (lane >> 3) + 8 * j; const LAS float* s = scr + (8 * c) * 33 + n;
        u32x4 o; o.x = cvt_pk_bf16(s[0 * 33], s[1 * 33]); o.y = cvt_pk_bf16(s[2 * 33], s[3 * 33]); o.z = cvt_pk_bf16(s[4 * 33], s[5 * 33]); o.w = cvt_pk_bf16(s[6 * 33], s[7 * 33]);
        *(u32x4*)(WT + (size_t)(dst_row0 + n) * K + k0 + 8 * c) = o; }
    LDS_WAIT(); asm volatile("" ::: "memory");
}
template <int MAP> DI int map_row(int n0) {
    if (MAP == 1) { const int j = n0 < DFF ? n0 : n0 - DFF; return (j >> 7) * 256 + (n0 < DFF ? 0 : 128) + (j & 127); }
    if (MAP == 2) { if (n0 >= 1024 && n0 < 3072) { const int j = (n0 - 1024) & 1023; return 1024 + (j >> 7) * 256 + (n0 < 2048 ? 0 : 128) + (j & 127); } return n0; }
    return n0;
}
template <int MAP> DI void convert_weight(const float* W, int K, int N, bf16* WT, const float* gain, LAS float* scr, int gw, int ngw, int lane) {
    const int nblk = N / 32, items = (K / 64) * nblk;
    int it = gw; if (it >= items) return;
    float ra[32], rb[32];
    tr_load(ra, W, N, 64 * (it / nblk), 32 * (it % nblk), lane);
    for (;;) {
        int nx = it + ngw; bool hn = nx < items;
        if (hn) tr_load(rb, W, N, 64 * (nx / nblk), 32 * (nx % nblk), lane);
        tr_finish(ra, K, WT, map_row<MAP>(32 * (it % nblk)), gain, scr, 64 * (it / nblk), lane);
        if (!hn) break;
        it = nx; nx = it + ngw; hn = nx < items;
        if (hn) tr_load(ra, W, N, 64 * (nx / nblk), 32 * (nx % nblk), lane);
        tr_finish(rb, K, WT, map_row<MAP>(32 * (it % nblk)), gain, scr, 64 * (it / nblk), lane);
        if (!hn) break;
        it = nx;
    }
}

struct CvtItem { const float* W; bf16* WT; const float* gain; int K, N, map, it; };
template <int LIST> DI bool cvt_decode(int g, const float* const* in, unsigned char* ws, CvtItem& c);
DI void cvt_load(float (&r)[32], const CvtItem& c, int lane) { const int nblk = c.N >> 5; tr_load(r, c.W, c.N, 64 * (c.it / nblk), 32 * (c.it % nblk), lane); }
DI void cvt_finish(float (&r)[32], const CvtItem& c, LAS float* scr, int lane) { const int nblk = c.N >> 5, n0 = 32 * (c.it % nblk);
    const int dst = c.map == 1 ? map_row<1>(n0) : c.map == 2 ? map_row<2>(n0) : n0; tr_finish(r, c.K, c.WT, dst, c.gain, scr, 64 * (c.it / nblk), lane); }
template <int LIST> DI void convert_list(const float* const* in, unsigned char* ws, LAS float* scr, int gw, int ngw, int lane) {
    int g = gw; CvtItem ca, cb; if (!cvt_decode<LIST>(g, in, ws, ca)) return;
    float ra[32], rb[32];
    cvt_load(ra, ca, lane);
    for (;;) {
        bool hn = cvt_decode<LIST>(g + ngw, in, ws, cb);
        if (hn) cvt_load(rb, cb, lane);
        cvt_finish(ra, ca, scr, lane);
        if (!hn) break;
        g += ngw; hn = cvt_decode<LIST>(g + ngw, in, ws, ca);
        if (hn) cvt_load(ra, ca, lane);
        cvt_finish(rb, cb, scr, lane);
        if (!hn) break;
        g += ngw;
    }
}

DI int crow(int i, int h) { return (i & 3) + 8 * (i >> 2) + 4 * h; }
constexpr int SB_KROW = 272, SB_VROW = 72, SB_KB = 32 * SB_KROW, SB_VB = 128 * SB_VROW, SB_BUF = SB_KB + SB_VB;

DI void sb_unit(LAS unsigned char* lds, bf16* Q  , const bf16* Kb, const bf16* Vt, int b, int hh, int qb, int tid, int wave, int lane) {
    const int r = lane & 31, h = lane >> 5, q0 = qb * 256;
    bf16* qp = Q + (size_t)(b * SEQ + q0 + wave * 32 + r) * 1024 + hh * 128;
    bf16x8 qf[8];
#pragma unroll
    for (int s = 0; s < 8; ++s) qf[s] = *(const bf16x8*)(qp + 16 * s + 8 * h);
    f32x16 o[4];
#pragma unroll
    for (int d = 0; d < 4; ++d)
#pragma unroll
        for (int i = 0; i < 16; ++i) o[d][i] = 0.f;
    float carry = 1.f; bool alive = true;
    volatile LAS int* fl = (volatile LAS int*)(lds + 2 * SB_BUF);
    const int nkt = (q0 + 256) / 32, dt = qb * 8 + wave;
    const int kr_ = tid >> 4, kch = tid & 15;
    const bf16* kg = Kb + (size_t)(b * SEQ + kr_) * 1024 + hh * 128 + kch * 8;
    const unsigned kl = kr_ * SB_KROW + kch * 16;
    const int vd = tid >> 2, vch = tid & 3;
    const bf16* vg = Vt + ((size_t)(b * 8 + hh) * 128 + vd) * SEQ + vch * 8;
    const unsigned vl = SB_KB + vd * SB_VROW + vch * 16;
    u32x4 kreg = *(const u32x4*)(kg + (size_t)(nkt - 1) * 32 * 1024), vreg = *(const u32x4*)(vg + (nkt - 1) * 32);
    *(LAS u32x4*)(lds + kl) = kreg; *(LAS u32x2*)(lds + vl) = (u32x2){vreg.x, vreg.y}; *(LAS u32x2*)(lds + vl + 8) = (u32x2){vreg.z, vreg.w};
    __syncthreads();
    for (int kt = nkt - 1; kt >= 0; --kt) {
        const int cur = (nkt - 1 - kt) & 1;
        LAS unsigned char* kb = lds + cur * SB_BUF; LAS unsigned char* vb = kb + SB_KB;
        if (kt > 0) { kreg = *(const u32x4*)(kg + (size_t)(kt - 1) * 32 * 1024); vreg = *(const u32x4*)(vg + (kt - 1) * 32); }
        if (kt <= dt && alive) {
            f32x16 x;
#pragma unroll
            for (int i = 0; i < 16; ++i) x[i] = 0.f;
#pragma unroll
            for (int s = 0; s < 8; ++s) { const bf16x8 a = *(const LAS bf16x8*)(kb + r * SB_KROW + (16 * s + 8 * h) * 2); x = MFMA32(a, qf[s], x); }
            float bt[16], om[16];
#pragma unroll
            for (int i = 0; i < 16; ++i) { const float e = __builtin_amdgcn_exp2f(-x[i]); const float bb = __builtin_amdgcn_rcpf(1.f + e); bt[i] = bb; om[i] = 1.f - bb; }
            if (kt == dt) {
#pragma unroll
                for (int i = 0; i < 16; ++i) { const bool valid = crow(i, h) < r; bt[i] = valid ? bt[i] : 0.f; om[i] = valid ? om[i] : 1.f; }
            }
            float G[4], PG[4];
#pragma unroll
            for (int m = 0; m < 4; ++m) { G[m] = (om[4 * m] * om[4 * m + 1]) * (om[4 * m + 2] * om[4 * m + 3]); PG[m] = __shfl_xor(G[m], 32); }
            const float T0 = G[0] * PG[0], T1 = G[1] * PG[1], T2 = G[2] * PG[2], T3 = G[3] * PG[3];
            float R[4]; R[3] = 1.f; R[2] = T3; R[1] = T3 * T2; R[0] = R[1] * T1;
            const float total = R[0] * T0;
            float p[16];
#pragma unroll
            for (int m = 0; m < 4; ++m) { float a = carry * R[m] * (h == 0 ? PG[m] : 1.f);
                p[4 * m + 3] = bt[4 * m + 3] * a; a *= om[4 * m + 3];
                p[4 * m + 2] = bt[4 * m + 2] * a; a *= om[4 * m + 2];
                p[4 * m + 1] = bt[4 * m + 1] * a; a *= om[4 * m + 1];
                p[4 * m + 0] = bt[4 * m + 0] * a; }
            carry *= total;
            alive = __builtin_amdgcn_ballot_w64(carry != 0.f) != 0ull;
            u32x4 w0, w1;
            w0.x = cvt_pk_bf16(p[0], p[1]); w0.y = cvt_pk_bf16(p[2], p[3]); w0.z = cvt_pk_bf16(p[4], p[5]); w0.w = cvt_pk_bf16(p[6], p[7]);
            w1.x = cvt_pk_bf16(p[8], p[9]); w1.y = cvt_pk_bf16(p[10], p[11]); w1.z = cvt_pk_bf16(p[12], p[13]); w1.w = cvt_pk_bf16(p[14], p[15]);
            const bf16x8 pf0 = __builtin_bit_cast(bf16x8, w0), pf1 = __builtin_bit_cast(bf16x8, w1);
#pragma unroll
            for (int db = 0; db < 4; ++db)
#pragma unroll
                for (int s = 0; s < 2; ++s) { const LAS unsigned char* vp = vb + (32 * db + r) * SB_VROW + (16 * s + 4 * h) * 2;
                    const u32x2 lo = *(const LAS u32x2*)vp, hi = *(const LAS u32x2*)(vp + 16);
                    const u32x4 av = {lo.x, lo.y, hi.x, hi.y};
                    o[db] = MFMA32(__builtin_bit_cast(bf16x8, av), s ? pf1 : pf0, o[db]); }
        }
        if (kt > 0) { LAS unsigned char* nb = lds + (cur ^ 1) * SB_BUF;
            *(LAS u32x4*)(nb + kl) = kreg; *(LAS u32x2*)(nb + vl) = (u32x2){vreg.x, vreg.y}; *(LAS u32x2*)(nb + vl + 8) = (u32x2){vreg.z, vreg.w}; }
        if (lane == 0) fl[cur * 8 + wave] = (kt <= dt && !alive) ? 1 : 0;
        __syncthreads();
        { int nd = 0;
#pragma unroll
          for (int w = 0; w < 8; ++w) nd += fl[cur * 8 + w];
          if (nd == 8) break; }
    }
#pragma unroll
    for (int db = 0; db < 4; ++db)
#pragma unroll
        for (int g = 0; g < 4; ++g) { u32x2 w; w.x = cvt_pk_bf16(o[db][4 * g], o[db][4 * g + 1]); w.y = cvt_pk_bf16(o[db][4 * g + 2], o[db][4 * g + 3]);
            *(u32x2*)(qp + 32 * db + 8 * g + 4 * h) = w; }
}

static_assert(2 * SB_BUF + 64 <= LDS_RING, "attention LDS");

#define XB_TMO      128
#define XB_XCNT(j)  (256  + 64 * (j))
#define XB_XSUB(j)  (1280 + 64 * (j))
#define XB_XGEN(j)  (2304 + 64 * (j))
#define XB_TOP      3328
#define XB_TOPGEN   3392
#define XCD_BAR_WORDS 3456
#define XB_SPIN_CAP (1u << 18)

__device__ __forceinline__ unsigned xb_ld(unsigned* p)              { return __hip_atomic_load(p, __ATOMIC_RELAXED, __HIP_MEMORY_SCOPE_AGENT); }
__device__ __forceinline__ unsigned xb_add(unsigned* p, unsigned v) { return __hip_atomic_fetch_add(p, v, __ATOMIC_RELAXED, __HIP_MEMORY_SCOPE_AGENT); }
__device__ __forceinline__ unsigned xb_xcc_id() { return (unsigned)__builtin_amdgcn_s_getreg((3 << 11) | 20) & 0xFu; }
#define XB_SPIN(cond, bar) do { unsigned _sp = 0; while (cond) { __builtin_amdgcn_s_sleep(4); \
    if ((++_sp & 255u) == 0u) { if (xb_ld(&(bar)[XB_TMO])) break; if (_sp > XB_SPIN_CAP) { atomicAdd(&(bar)[XB_TMO], 1u); break; } } } } while (0)

struct XcdBarrier {
    unsigned* bar; unsigned x;
    volatile LAS unsigned* st;
};

__device__ __forceinline__ XcdBarrier xcd_barrier_post(unsigned* bar, volatile LAS unsigned* st) {
    XcdBarrier b; b.bar = bar; b.x = xb_xcc_id(); b.st = st;
    if (threadIdx.x == 0) (void)xb_add(&bar[XB_XCNT(b.x)], 1u);
    return b;
}
__device__ __forceinline__ void xcd_barrier_complete(unsigned* bar, unsigned x, unsigned& nloc, unsigned& nx) {
    const unsigned G = gridDim.x * gridDim.y * gridDim.z;
    unsigned sum, cnt, mine, sp = 0u;
    for (;;) {
        sum = 0u; cnt = 0u; mine = 0u;
#pragma unroll
        for (unsigned j = 0; j < 16; ++j) { const unsigned c = xb_ld(&bar[XB_XCNT(j)]); sum += c; cnt += (c > 0u) ? 1u : 0u; mine = (j == x) ? c : mine; }
        if (sum == G) break;
        __builtin_amdgcn_s_sleep(1);
        if ((++sp & 255u) == 0u) { if (xb_ld(&bar[XB_TMO])) break; if (sp > XB_SPIN_CAP) { atomicAdd(&bar[XB_TMO], 1u); break; } }
    }
    nloc = mine > 0u ? mine : 1u; nx = cnt > 0u ? cnt : 1u;
}

__device__ __forceinline__ void xcd_barrier(const XcdBarrier& b) {
    asm volatile("s_waitcnt vmcnt(0)" ::: "memory");
    __syncthreads();
    if (threadIdx.x == 0) {
        unsigned* bar = b.bar;
        __builtin_amdgcn_s_waitcnt(0);
        unsigned nloc = b.st[0], nx = b.st[1];
        if (nloc == 0u) { xcd_barrier_complete(bar, b.x, nloc, nx); b.st[0] = nloc; b.st[1] = nx; }
        const unsigned old = xb_add(&bar[XB_XSUB(b.x)], 1u);
        const unsigned gen = old / nloc;
        if (old + 1u == (gen + 1u) * nloc) {
            __builtin_amdgcn_fence(__ATOMIC_RELEASE, "agent");
            asm volatile("s_waitcnt vmcnt(0)" ::: "memory");
            const unsigned og = xb_add(&bar[XB_TOP], 1u);
            const unsigned tg = og / nx;
            if (og + 1u == (tg + 1u) * nx) xb_add(&bar[XB_TOPGEN], 1u);
            else XB_SPIN(xb_ld(&bar[XB_TOPGEN]) == tg, bar);
            __builtin_amdgcn_fence(__ATOMIC_ACQUIRE, "agent");
            xb_add(&bar[XB_XGEN(b.x)], 1u);
            asm volatile("s_waitcnt vmcnt(0)" ::: "memory");
        } else {
            XB_SPIN(xb_ld(&bar[XB_XGEN(b.x)]) == gen, bar);
            __builtin_amdgcn_fence(__ATOMIC_ACQUIRE, "agent");
            asm volatile("s_waitcnt vmcnt(0)" ::: "memory");
        }
    }
    __syncthreads();
}

#define XL_SUB(j) (5120 + 64 * (j))
#define XL_GEN(j) (6144 + 64 * (j))
#define XL_BAD 7168
__device__ __forceinline__ void xcd_local_barrier(const XcdBarrier& b) {
    asm volatile("s_waitcnt vmcnt(0)" ::: "memory");
    __syncthreads();
    if (threadIdx.x == 0) {
        unsigned* bar = b.bar;
        __builtin_amdgcn_s_waitcnt(0);
        const unsigned nloc = b.st[0];
        const unsigned old = xb_add(&bar[XL_SUB(b.x)], 1u);
        const unsigned gen = old / nloc;
        if (old + 1u == (gen + 1u) * nloc) xb_add(&bar[XL_GEN(b.x)], 1u);
        else XB_SPIN(xb_ld(&bar[XL_GEN(b.x)]) == gen, bar);
        __builtin_amdgcn_fence(__ATOMIC_ACQUIRE, "agent");
        asm volatile("s_waitcnt vmcnt(0)" ::: "memory");
    }
    __syncthreads();
}

struct Order1 { pg8::StaticOrder Sa, Sk, Sv; unsigned char* ws; int na;
    DI void init(unsigned char* ws_, int G, int c) { ws = ws_; Sa.init(M, 2 * DFF, G, c); Sk.init(MM, DM, G, (c + 128) % G); Sv.init(DM, MM, G, (c + 96) % G); const int nu = (M / 256) * (2 * DFF / 256); na = c < nu ? (nu - c + G - 1) / G : 0; }
    DI bool next(int i, pg8::Unit& u) const { if (Sa.next(i, u)) return true; if (i == na) { if (Sk.next(0, u)) { u.job = 1; return true; } if (Sv.next(0, u)) { u.job = 2; return true; } } return false; }
    DI const char* baseA(const pg8::Gemm&, const pg8::Unit& u) const { return (const char*)ws + (u.job == 0 ? WS_S0 : u.job == 1 ? WS_MN : WS_WCKV + (size_t)DM * DM * 2); }
    DI const char* baseB(const pg8::Gemm&, const pg8::Unit& u) const { return (const char*)ws + (u.job == 0 ? WS_WGU : u.job == 1 ? WS_WCKV : WS_MN); }
    DI void a_ready(const pg8::Unit&) const {} DI void done(const pg8::Unit&) const {}
};
struct Epi1 { static constexpr bool PERM = true, AFTER_DRAIN = false; unsigned char* ws;
    DI void operator()(const pg8::f32x4 (&acc)[2][2][4][2], const pg8::Unit& u, int wr, int wc, int fr, int fq) const {
        if (u.job == 0) { pg8::EpiSwiGLU e{(pg8::bf16_t*)(ws + WS_S0 + SLOT), (const float*)(ws + WS_SSQ), DFF}; e(acc, u, wr, wc, fr, fq); }
        else if (u.job == 1) { pg8::EpiTileC e{(pg8::bf16_t*)(ws + WS_KX), nullptr, 1.f, 0}; e(acc, u, wr, wc, fr, fq); }
        else { pg8::EpiTileC e{(pg8::bf16_t*)(ws + WS_VXT), nullptr, 1.f, 1}; e(acc, u, wr, wc, fr, fq); }
    }
};
struct Order3 { pg8::StaticOrder Sa, Sv; unsigned char* ws;
    DI void init(unsigned char* ws_, int G, int c) { ws = ws_; Sa.init(M, 5120, G, c); Sv.init(DM, M, G, c); }
    DI bool next(int i, pg8::Unit& u) const { if (Sa.next(i, u)) return true; const int na = (1280 - Sa.c + Sa.G - 1) / Sa.G; if (Sv.next(i - na, u)) { u.job = 1; return true; } return false; }
    DI const char* baseA(const pg8::Gemm&, const pg8::Unit& u) const { return (const char*)ws + (u.job == 0 ? WS_S0 : WS_WIN + (size_t)5120 * DM * 2); }
    DI const char* baseB(const pg8::Gemm&, const pg8::Unit& u) const { return (const char*)ws + (u.job == 0 ? WS_WIN : WS_S0); }
    DI void a_ready(const pg8::Unit&) const {} DI void done(const pg8::Unit&) const {}
};
struct Epi3 { static constexpr bool PERM = true, AFTER_DRAIN = false; unsigned char* ws;
    DI void operator()(const pg8::f32x4 (&acc)[2][2][4][2], const pg8::Unit& u, int wr, int wc, int fr, int fq) const {
        const float* ssq1 = (const float*)(ws + WS_SSQ) + M;
        if (u.job == 0) { pg8::EpiMixIn e{(pg8::bf16_t*)(ws + WS_S0 + SLOT), (pg8::bf16_t*)(ws + WS_S0 + 2 * SLOT), (pg8::bf16_t*)(ws + WS_S0 + 3 * SLOT), (pg8::bf16_t*)(ws + WS_S0 + 4 * SLOT), ssq1, QSCALE_SB}; e(acc, u, wr, wc, fr, fq); }
        else { pg8::EpiVt e{(pg8::bf16_t*)(ws + WS_S0 + 5 * SLOT), ssq1}; e(acc, u, wr, wc, fr, fq); }
    }
};
struct Order5 { pg8::StaticOrder S; unsigned char* ws;
    DI void init(unsigned char* ws_, int G, int c) { ws = ws_; S.init(M, DM, G, c); }
    DI bool next(int i, pg8::Unit& u) const { if (i >= 4) return false; if (!S.next(0, u)) return false; u.job = i; return true; }
    DI const char* baseA(const pg8::Gemm&, const pg8::Unit& u) const { return (const char*)ws + (u.job == 1 ? WS_S0 + SLOT : u.job == 3 ? WS_S0 + 3 * SLOT : WS_S0); }
    DI const char* baseB(const pg8::Gemm&, const pg8::Unit& u) const { return (const char*)ws + (u.job == 0 ? WS_WIN + (size_t)6144 * DM * 2 : u.job == 1 ? WS_WCO : u.job == 2 ? WS_WIN + (size_t)7168 * DM * 2 : WS_WAO); }
    DI void a_ready(const pg8::Unit&) const {} DI void done(const pg8::Unit&) const {}
};
struct Epi5 { static constexpr bool PERM = true, AFTER_DRAIN = false; unsigned char* ws; const float* bgate;
    DI void operator()(const pg8::f32x4 (&acc)[2][2][4][2], const pg8::Unit& u, int wr, int wc, int fr, int fq) const {
        const float* ssq1 = (const float*)(ws + WS_SSQ) + M; pg8::bf16_t* S4 = (pg8::bf16_t*)(ws + WS_S0 + 4 * SLOT); pg8::bf16_t* S5 = (pg8::bf16_t*)(ws + WS_S0 + 5 * SLOT);
        if (u.job == 0) { pg8::EpiGen<1> e{S4, DM, ssq1, 1.f, bgate}; e(acc, u, wr, wc, fr, fq); }
        else if (u.job == 1) { pg8::EpiGateMul<0> e{S4, nullptr}; e(acc, u, wr, wc, fr, fq); }
        else if (u.job == 2) { pg8::EpiGen<1> e{S5, DM, ssq1, 1.f, bgate + DM}; e(acc, u, wr, wc, fr, fq); }
        else { pg8::EpiGateMul<1> e{S5, S4}; e(acc, u, wr, wc, fr, fq); }
    }
};
#define GEMM_MULTI(OrderT, EpiT, Kv, ...) do { pg8::Gemm g_{nullptr, nullptr, 0, 0, (Kv)}; OrderT S_; S_.init(ws, G, c); EpiT E_{__VA_ARGS__}; pg8::gemm_phase<EpiT, OrderT, true, true>(lds, g_, S_, E_); } while (0)

struct Params { const float* in[21]; float* out; unsigned char* ws; };
enum { I_X = 0, I_MEM, I_G_FFN1, I_W_FFN1_GU, I_W_FFN1_DOWN, I_G_MIX, I_W_IN, I_B_GATE, I_CONV_W, I_W_CONV_OUT, I_W_ATTN_OUT, I_W_O, I_G_CROSS, I_G_MEM, I_W_CQ, I_W_CKV, I_W_CO,
       I_G_FFN2, I_W_FFN2_GU, I_W_FFN2_DOWN, I_G_FINAL };

template <> DI bool cvt_decode<0>(int g, const float* const* in, unsigned char* ws, CvtItem& c) {
    if (g >= 7808) return false;
    if (g < 2816) { c.W = in[I_W_FFN1_GU]; c.WT = (bf16*)(ws + WS_WGU); c.gain = in[I_G_FFN1]; c.K = DM; c.N = 2 * DFF; c.map = 1; c.it = g; }
    else if (g < 3840) { c.W = in[I_W_CKV]; c.WT = (bf16*)(ws + WS_WCKV); c.gain = nullptr; c.K = DM; c.N = 2 * DM; c.map = 0; c.it = g - 2816; }
    else if (g < 5248) { c.W = in[I_W_FFN1_DOWN]; c.WT = (bf16*)(ws + WS_WD); c.gain = nullptr; c.K = DFF; c.N = DM; c.map = 0; c.it = g - 3840; }
    else { const int j = (g - 5248) >> 9; c.it = (g - 5248) & 511; c.K = DM; c.N = DM; c.map = 0;
        c.W = in[j == 0 ? I_W_CONV_OUT : j == 1 ? I_W_ATTN_OUT : j == 2 ? I_W_O : j == 3 ? I_W_CQ : I_W_CO];
        c.WT = (bf16*)(ws + (j == 0 ? WS_WCO : j == 1 ? WS_WAO : j == 2 ? WS_WO : j == 3 ? WS_WCQ : WS_WXO));
        c.gain = j == 3 ? in[I_G_CROSS] : nullptr; }
    return true;
}
template <> DI bool cvt_decode<1>(int g, const float* const* in, unsigned char* ws, CvtItem& c) {
    if (g >= 4224) return false;
    if (g < 2816) { c.W = in[I_W_FFN2_GU]; c.WT = (bf16*)(ws + WS_WGU); c.gain = in[I_G_FFN2]; c.K = DM; c.N = 2 * DFF; c.map = 1; c.it = g; }
    else { c.W = in[I_W_FFN2_DOWN]; c.WT = (bf16*)(ws + WS_WD); c.gain = nullptr; c.K = DFF; c.N = DM; c.map = 0; c.it = g - 2816; }
    return true;
}

#define GEMM(EpiT, Aptr, Bptr, Mv, Nv, Kv, cid, ...) do { pg8::Gemm g_{(const pg8::bf16_t*)(Aptr), (const pg8::bf16_t*)(Bptr), (Mv), (Nv), (Kv)}; pg8::StaticOrder S_; S_.init((Mv), (Nv), G, (cid)); \
        EpiT E_{__VA_ARGS__}; pg8::gemm_phase<EpiT, pg8::StaticOrder, true, true>(lds, g_, S_, E_); } while (0)

__global__ void __launch_bounds__(NTHREADS, 2) fwd_megakernel(Params P) {
    extern __shared__ __attribute__((aligned(16))) unsigned char lds_raw[];
    LAS unsigned char* lds = (LAS unsigned char*)lds_raw;
    cg::grid_group grid = cg::this_grid();
    const int tid = threadIdx.x, lane = tid & 63, wave = __builtin_amdgcn_readfirstlane(tid >> 6);
    const int G = gridDim.x, c = blockIdx.x;
    const int gw = c * NWAVES + wave, ngw = G * NWAVES;
    unsigned char* ws = P.ws;
    bf16* WGU = (bf16*)(ws + WS_WGU); bf16* WD = (bf16*)(ws + WS_WD); bf16* WIN = (bf16*)(ws + WS_WIN);
    bf16* WCO = (bf16*)(ws + WS_WCO); bf16* WAO = (bf16*)(ws + WS_WAO); bf16* WO = (bf16*)(ws + WS_WO); bf16* WCQ = (bf16*)(ws + WS_WCQ);
    bf16* WCKV = (bf16*)(ws + WS_WCKV); bf16* WXO = (bf16*)(ws + WS_WXO);
    bf16* MN = (bf16*)(ws + WS_MN); bf16* KX = (bf16*)(ws + WS_KX); bf16* VXT = (bf16*)(ws + WS_VXT);
    float* SSQ = (float*)(ws + WS_SSQ);
    float *ssq0 = SSQ, *ssq1 = SSQ + M, *ssq2 = SSQ + 2 * M, *ssq3 = SSQ + 3 * M, *ssq4 = SSQ + 4 * M;
    bf16* S0 = (bf16*)(ws + WS_S0); bf16* S1 = (bf16*)(ws + WS_S0 + SLOT); bf16* S2 = (bf16*)(ws + WS_S0 + 2 * SLOT); bf16* S3 = (bf16*)(ws + WS_S0 + 3 * SLOT);
    bf16* S4 = (bf16*)(ws + WS_S0 + 4 * SLOT); bf16* S5 = (bf16*)(ws + WS_S0 + 5 * SLOT);
    LAS float* scr = (LAS float*)(lds + wave * 16384);
    volatile LAS unsigned* bst = (volatile LAS unsigned*)(lds + LDS_RING);
    if (tid < 16) bst[tid] = 0u;
    __syncthreads();
    const XcdBarrier xbar = xcd_barrier_post((unsigned*)(ws + WS_BAR), bst);
    if (tid == 0) (void)__hip_atomic_fetch_or((unsigned*)(ws + WS_BAR) + XL_BAD + (c & 7), (1u << xb_xcc_id()) | (G != 256 ? 0x80000000u : 0u), __ATOMIC_RELAXED, __HIP_MEMORY_SCOPE_AGENT);

    {
        convert_list<0>(P.in, ws, scr, gw, ngw, lane);
        for (int m0 = 4 * gw; m0 < M; m0 += 4 * ngw) {
            f32x4 v[4][4];
#pragma unroll
            for (int q = 0; q < 4; ++q)
#pragma unroll
                for (int j = 0; j < 4; ++j) v[q][j] = __builtin_nontemporal_load((const f32x4*)(P.in[I_X] + (size_t)(m0 + q) * DM) + lane + 64 * j);
#pragma unroll
            for (int q = 0; q < 4; ++q) { unsigned long long* o8 = (unsigned long long*)(S0 + (size_t)(m0 + q) * DM) + lane; float s = 0.f;
#pragma unroll
                for (int j = 0; j < 4; ++j) { const f32x4 t = v[q][j]; s += (t.x * t.x + t.y * t.y) + (t.z * t.z + t.w * t.w);
                    o8[64 * j] = (unsigned long long)cvt_pk_bf16(t.x, t.y) | ((unsigned long long)cvt_pk_bf16(t.z, t.w) << 32); }
                s = wave_sum(s); if (lane == 0) ssq0[m0 + q] = s; }
        }
        for (int m = gw; m < MM; m += ngw) {
            const f32x4* xr = (const f32x4*)(P.in[I_MEM] + (size_t)m * DM) + lane; const f32x4* gr = (const f32x4*)P.in[I_G_MEM] + lane;
            unsigned long long* o8 = (unsigned long long*)(MN + (size_t)m * DM) + lane; f32x4 v[4]; float s = 0.f;
#pragma unroll
            for (int j = 0; j < 4; ++j) { v[j] = xr[64 * j]; s += (v[j].x * v[j].x + v[j].y * v[j].y) + (v[j].z * v[j].z + v[j].w * v[j].w); }
            const float rs = rs_of(wave_sum(s));
#pragma unroll
            for (int j = 0; j < 4; ++j) { const f32x4 g = gr[64 * j]; const f32x4 y = v[j] * rs * g;
                o8[64 * j] = (unsigned long long)cvt_pk_bf16(y.x, y.y) | ((unsigned long long)cvt_pk_bf16(y.z, y.w) << 32); }
        }
        for (int i = c * NTHREADS + tid; i < 4 * M; i += G * NTHREADS) ssq1[i] = 0.f;
    }
    if (P.ws == nullptr) grid.sync();
    xcd_barrier(xbar);
    bool fastb;
    {
        if (tid == 0) { unsigned un = 0u; bool one = true;
#pragma unroll
            for (int j = 0; j < 8; ++j) { const unsigned m = xb_ld((unsigned*)(ws + WS_BAR) + XL_BAD + j); one = one && (__builtin_popcount(m) == 1); un |= m; }
            bst[4] = (one && __builtin_popcount(un) == 8 && (un >> 16) == 0u) ? 1u : 0u; }
        __syncthreads();
        fastb = __builtin_amdgcn_readfirstlane((int)bst[4]) != 0; }
#define SEAM_LOCAL() do { if (fastb) xcd_local_barrier(xbar); else xcd_barrier(xbar); } while (0)

    GEMM_MULTI(Order1, Epi1, DM, ws);
    if (G != 256 || c >= 192) {
        const int gw2 = G == 256 ? (c - 192) * NWAVES + wave : gw, ngw2 = G == 256 ? 64 * NWAVES : ngw;
        convert_weight<2>(P.in[I_W_IN], DM, NIN, WIN, P.in[I_G_MIX], scr, gw2, ngw2, lane);
    }
    SEAM_LOCAL();

    GEMM(pg8::EpiResid, S1, WD, M, DM, DFF, c, (pg8::bf16_t*)S0, ssq1, 0.5f);
    xcd_barrier(xbar);

    GEMM_MULTI(Order3, Epi3, DM, ws);
    SEAM_LOCAL();

    {
        convert_list<1>(P.in, ws, scr, gw, ngw, lane);
        const float* cw = P.in[I_CONV_W];
        const int nbb = (G & 7) == 0 ? G >> 3 : 0;
        for (int idx = (nbb ? (c >> 3) : c) * NTHREADS + tid; idx < (nbb ? SEQ * 64 : M * 64); idx += (nbb ? nbb : G) * NTHREADS) {
            const int t = (idx >> 7) * 2 + (nbb ? (c & 7) * SEQ : 0), c8 = (idx & 127) * 8, s = t & (SEQ - 1); const size_t off = (size_t)t * 1024 + c8;
            const u32x4 z4 = {0u, 0u, 0u, 0u};
            const u32x4 r1 = *(const u32x4*)(S2 + off + 1024), r0 = *(const u32x4*)(S2 + off), rm1 = s >= 1 ? *(const u32x4*)(S2 + off - 1024) : z4, rm2 = s >= 2 ? *(const u32x4*)(S2 + off - 2048) : z4;
            const u32x4 cbr0 = *(const u32x4*)(S1 + off), cbr1 = *(const u32x4*)(S1 + off + 1024);
            f32x4 a0, a1, b0, b1, e0, e1, g0, g1, cb0, cb1, cc0, cc1;
            unpack8(r1, g0, g1); unpack8(r0, a0, a1); unpack8(rm1, b0, b1); unpack8(rm2, e0, e1); unpack8(cbr0, cb0, cb1); unpack8(cbr1, cc0, cc1);
            const f32x4 w00 = *(const f32x4*)(cw + c8), w01 = *(const f32x4*)(cw + c8 + 4), w10 = *(const f32x4*)(cw + 1024 + c8), w11 = *(const f32x4*)(cw + 1024 + c8 + 4),
                        w20 = *(const f32x4*)(cw + 2048 + c8), w21 = *(const f32x4*)(cw + 2048 + c8 + 4);
            *(u32x4*)(S1 + off) = pack8(cb0 * (w00 * e0 + w10 * b0 + w20 * a0), cb1 * (w01 * e1 + w11 * b1 + w21 * a1));
            *(u32x4*)(S1 + off + 1024) = pack8(cc0 * (w00 * b0 + w10 * a0 + w20 * g0), cc1 * (w01 * b1 + w11 * a1 + w21 * g1));
        }
        __syncthreads();
        if (nbb) { for (int j = c >> 3; j < 32; j += nbb) { const int b = c & 7, hh = j >> 2, pr = j & 3;
            sb_unit(lds, S3, S4, S5, b, hh, 7 - pr, tid, wave, lane);
            sb_unit(lds, S3, S4, S5, b, hh, pr, tid, wave, lane); } }
        else for (int u = c; u < 256; u += G) { const int bh = u >> 2, pr = u & 3;
            sb_unit(lds, S3, S4, S5, bh >> 3, bh & 7, 7 - pr, tid, wave, lane);
            sb_unit(lds, S3, S4, S5, bh >> 3, bh & 7, pr, tid, wave, lane); }
    }
    xcd_barrier(xbar);

    GEMM_MULTI(Order5, Epi5, DM, ws, P.in[I_B_GATE]);
    SEAM_LOCAL();

    GEMM(pg8::EpiResid, S5, WO, M, DM, DM, c, (pg8::bf16_t*)S0, ssq2, 1.f);
    SEAM_LOCAL();

    GEMM(pg8::EpiTileC, S0, WCQ, M, DM, DM, c, (pg8::bf16_t*)S1, ssq2, QSCALE_X, 0);
    {
#define SYNC_OWN() do { asm volatile("s_waitcnt vmcnt(0)" ::: "memory"); if (tid == 0) { __builtin_amdgcn_fence(__ATOMIC_ACQUIRE, "agent"); asm volatile("s_waitcnt vmcnt(0)" ::: "memory"); } __syncthreads(); } while (0)
        float* RS = (float*)(ws + WS_RSUM);
        pg8::StaticOrder So; So.init(M, DM, G, c);
        for (int i = 0;; ++i) { pg8::Unit u0; if (!So.next(i, u0)) break;
            const int tA = u0.pm * 4 + u0.pn, tB = (u0.pm >> 3) * 4 + u0.pn;
            SYNC_OWN();
            { pg8::Gemm g_{(const pg8::bf16_t*)S1, (const pg8::bf16_t*)KX, 0, 0, 256}; pg8::OrderOne S_{tA, tB}; pg8::EpiSoftmaxP E_{(pg8::bf16_t*)S3, RS};
              pg8::gemm_phase<pg8::EpiSoftmaxP, pg8::OrderOne, false, true>(lds, g_, S_, E_); }
            SYNC_OWN();
            { pg8::Gemm g_{(const pg8::bf16_t*)S3, (const pg8::bf16_t*)VXT, 0, 0, 256}; pg8::OrderOne S_{tA, tB}; pg8::EpiO E_{(pg8::bf16_t*)S2, RS};
              pg8::gemm_phase<pg8::EpiO, pg8::OrderOne, true, true>(lds, g_, S_, E_); }
        }
    }
    SEAM_LOCAL();

    GEMM(pg8::EpiResid, S2, WXO, M, DM, DM, c, (pg8::bf16_t*)S0, ssq3, 1.f);
    SEAM_LOCAL();

    GEMM(pg8::EpiSwiGLU, S0, WGU, M, 2 * DFF, DM, c, (pg8::bf16_t*)S1, ssq3, DFF);
    SEAM_LOCAL();

    GEMM(pg8::EpiFinal, S1, WD, M, DM, DFF, c, (const pg8::bf16_t*)S0, P.out, ssq4, 0.5f, P.in[I_G_FINAL], (unsigned*)(ws + WS_PANEL));
}

extern "C" void kernel_launch(void* const* d_in, const int* in_sizes, int n_in, void* d_out, int out_size, void* d_ws, size_t ws_size, hipStream_t stream) {
    static int grid_blocks = 0;
    if (grid_blocks == 0) {
        if (n_in != 21 || out_size != M * DM || ws_size < WS_END) { fprintf(stderr, "kernel_launch: unexpected problem (n_in %d, out %d, ws %zu)\n", n_in, out_size, ws_size); grid_blocks = -1; return; }
        int dev = 0, cus = 0, per_cu = 0;
        (void)hipGetDevice(&dev);
        (void)hipDeviceGetAttribute(&cus, hipDeviceAttributeMultiprocessorCount, dev);
        if (hipFuncSetAttribute((const void*)fwd_megakernel, hipFuncAttributeMaxDynamicSharedMemorySize, LDS_BYTES) != hipSuccess) { fprintf(stderr, "kernel_launch: hipFuncSetAttribute failed\n"); grid_blocks = -1; return; }
        if (hipOccupancyMaxActiveBlocksPerMultiprocessor(&per_cu, (const void*)fwd_megakernel, NTHREADS, LDS_BYTES) != hipSuccess || per_cu < 1) { fprintf(stderr, "kernel_launch: occupancy query failed (%d)\n", per_cu); (void)hipGetLastError(); grid_blocks = -1; return; }
        grid_blocks = cus * per_cu;
    }
    if (grid_blocks < 0) return;
    if (hipMemsetAsync((unsigned char*)d_ws + WS_BAR, 0, BAR_BYTES, stream) != hipSuccess) { fprintf(stderr, "kernel_launch: memset failed\n"); return; }
    Params p{};
    for (int i = 0; i < 21; ++i) p.in[i] = (const float*)d_in[i];
    p.out = (float*)d_out; p.ws = (unsigned char*)d_ws;
    void* args[] = {&p};
    hipError_t e = hipLaunchCooperativeKernel((const void*)fwd_megakernel, dim3(grid_blocks), dim3(NTHREADS), args, LDS_BYTES, stream);
    if (e != hipSuccess) fprintf(stderr, "cooperative launch failed: %s (grid %d)\n", hipGetErrorString(e), grid_blocks);
}
```
